# Optimizing an MI355X kernel written in HIP

```python
import math
import jax, jax.numpy as jnp
from jax import lax
import numpy as np

D_MODEL = 1024
BATCH = 4
SEQ = 8192
DEPTH = 2

CONV_WIDTH = 512
CONV_K = 3
N_HEADS = 16
HEAD_DIM = 64
N_KV_GROUPS = 4
HEADS_PER_GROUP = N_HEADS // N_KV_GROUPS
ATTN_WIDTH = N_HEADS * HEAD_DIM
KV_WIDTH = N_KV_GROUPS * HEAD_DIM
CMP_BLOCK = 32
CMP_STRIDE = 16
CMP_RATIO = CMP_BLOCK // CMP_STRIDE
CMP_HIDDEN = 128
SEL_BLOCK = 64
SEL_TOPN = 16
WINDOW = 512
Q_BLOCK = 128
D_FF = -(-8 * D_MODEL // (3 * 256)) * 256
ALPHA = (2.0 * DEPTH) ** 0.25
BETA = (8.0 * DEPTH) ** -0.25
LN_EPS = 1e-5
NEG_INF = -1e30
FORCE_BONUS = 1e4
IN_SIZES = [CONV_WIDTH] * 3 + [ATTN_WIDTH] + [KV_WIDTH] * 6 + [3 * N_HEADS, 2 * D_MODEL]
N_IN = sum(IN_SIZES)

kernel_name = "hybrid_shortconv_nsa_alibi_deepnorm"


def layer_norm(x, g, b):
    xf = x.astype(jnp.float32)
    mu = jnp.mean(xf, axis=-1, keepdims=True)
    var = jnp.mean(jnp.square(xf - mu), axis=-1, keepdims=True)
    y = (xf - mu) * lax.rsqrt(var + LN_EPS)
    return (y * g.astype(jnp.float32) + b.astype(jnp.float32)).astype(x.dtype)


def alibi_slopes():
    h = jnp.arange(1, N_HEADS + 1, dtype=jnp.float32)
    return (2.0 ** (-8.0 * h / N_HEADS)).reshape(N_KV_GROUPS, HEADS_PER_GROUP)


def masked_softmax(s, mask):
    p = jax.nn.softmax(jnp.where(mask, s, NEG_INF), axis=-1)
    return jnp.where(mask, p, 0.0)


def short_conv_mixer(b_gate, c_gate, xin, conv_w, w_out):
    u = c_gate * xin
    v = lax.conv_general_dilated(
        u, conv_w[:, None, :], window_strides=(1,), padding=((CONV_K - 1, 0),),
        dimension_numbers=("NWC", "WIO", "NWC"), feature_group_count=CONV_WIDTH)
    return (b_gate * v) @ w_out


def compress_blocks(kv, pos, w1, b1, w2):
    B_, G_, S_, dk = kv.shape
    n_chunks = S_ // CMP_STRIDE
    n_c = n_chunks - CMP_RATIO + 1
    chunks = kv.reshape(B_, G_, n_chunks, CMP_STRIDE, dk)
    blocks = jnp.concatenate([chunks[:, :, r:r + n_c] for r in range(CMP_RATIO)], axis=3)
    flat = (blocks + pos).reshape(B_, G_, n_c, CMP_BLOCK * dk)
    return jax.nn.gelu(flat @ w1 + b1) @ w2


def nsa_attention(q, k_cmp, v_cmp, k_slc, v_slc, k_win, v_win, gates, slopes):
    B_, G_, Hg, S_, dk = q.shape
    n_c = k_cmp.shape[2]
    n_sel = S_ // SEL_BLOCK
    topn = min(SEL_TOPN, n_sel)
    scale = HEAD_DIM ** -0.5
    slopes_ = slopes[None, :, :, None, None]
    cmp_end = jnp.arange(n_c) * CMP_STRIDE + CMP_BLOCK - 1
    ci = jnp.arange(n_c)[:, None]
    sj = jnp.arange(n_sel)[None, :]
    overlap = ((ci * CMP_STRIDE <= sj * SEL_BLOCK + SEL_BLOCK - 1)
               & (ci * CMP_STRIDE + CMP_BLOCK - 1 >= sj * SEL_BLOCK)).astype(jnp.float32)
    k_blocks = k_slc.reshape(B_, G_, n_sel, SEL_BLOCK, dk)
    v_blocks = v_slc.reshape(B_, G_, n_sel, SEL_BLOCK, dk)
    k_win_p = jnp.pad(k_win, ((0, 0), (0, 0), (WINDOW, 0), (0, 0)))
    v_win_p = jnp.pad(v_win, ((0, 0), (0, 0), (WINDOW, 0), (0, 0)))
    b_idx = jnp.arange(B_)[:, None, None, None]
    g_idx = jnp.arange(G_)[None, :, None, None]
    jj = jnp.arange(n_sel)
    sel_off = jnp.arange(SEL_BLOCK)
    win_off = jnp.arange(Q_BLOCK + WINDOW)

    def query_block(qb):
        q0 = qb * Q_BLOCK
        t = q0 + jnp.arange(Q_BLOCK)
        qc = lax.dynamic_slice_in_dim(q, q0, Q_BLOCK, axis=3) * scale
        gc = lax.dynamic_slice_in_dim(gates, q0, Q_BLOCK, axis=3)

        dist_c = t[:, None] - cmp_end[None, :]
        s_c = jnp.einsum("bghqd,bgcd->bghqc", qc, k_cmp).astype(jnp.float32)
        s_c = s_c - slopes_ * dist_c.astype(jnp.float32)
        p_c = masked_softmax(s_c, dist_c >= 0)
        o_c = jnp.einsum("bghqc,bgcd->bghqd", p_c.astype(v_cmp.dtype), v_cmp)

        imp = jnp.einsum("bgqc,cj->bgqj", p_c.sum(axis=2), overlap)
        cur = t // SEL_BLOCK
        forced = (jj[None, :] == 0) | (jj[None, :] == cur[:, None]) | (jj[None, :] == cur[:, None] - 1)
        imp = jnp.where(forced, imp + FORCE_BONUS, imp)
        imp = jnp.where(jj[None, :] <= cur[:, None], imp, NEG_INF)
        top_val, top_idx = lax.top_k(imp, topn)
        blk_ok = top_val > 0.5 * NEG_INF

        k_g = k_blocks[b_idx, g_idx, top_idx]
        v_g = v_blocks[b_idx, g_idx, top_idx]
        pos_s = top_idx[..., None] * SEL_BLOCK + sel_off
        dist_s = t[None, None, :, None, None] - pos_s
        mask_s = (dist_s >= 0) & blk_ok[..., None]
        s_s = jnp.einsum("bghqd,bgqnld->bghqnl", qc, k_g).astype(jnp.float32)
        s_s = s_s - slopes_[..., None] * dist_s[:, :, None].astype(jnp.float32)
        p_s = masked_softmax(s_s.reshape(B_, G_, Hg, Q_BLOCK, topn * SEL_BLOCK),
                             mask_s[:, :, None].reshape(B_, G_, 1, Q_BLOCK, topn * SEL_BLOCK))
        o_s = jnp.einsum("bghqm,bgqmd->bghqd", p_s.astype(v_g.dtype),
                         v_g.reshape(B_, G_, Q_BLOCK, topn * SEL_BLOCK, dk))

        kw = lax.dynamic_slice_in_dim(k_win_p, q0, Q_BLOCK + WINDOW, axis=2)
        vw = lax.dynamic_slice_in_dim(v_win_p, q0, Q_BLOCK + WINDOW, axis=2)
        pos_w = q0 - WINDOW + win_off
        dist_w = t[:, None] - pos_w[None, :]
        mask_w = (dist_w >= 0) & (dist_w < WINDOW) & (pos_w[None, :] >= 0)
        s_w = jnp.einsum("bghqd,bgkd->bghqk", qc, kw).astype(jnp.float32)
        s_w = s_w - slopes_ * dist_w.astype(jnp.float32)
        p_w = masked_softmax(s_w, mask_w)
        o_w = jnp.einsum("bghqk,bgkd->bghqd", p_w.astype(vw.dtype), vw)

        return gc[..., 0:1] * o_c + gc[..., 1:2] * o_s + gc[..., 2:3] * o_w

    out = lax.map(query_block, jnp.arange(S_ // Q_BLOCK))
    return out.transpose(1, 0, 4, 2, 3, 5).reshape(B_, S_, N_HEADS * HEAD_DIM)


def hybrid_mixer(x, w_in, conv_w, w_conv_out, cmp_pos, cmp_w1, cmp_b1, cmp_w2, w_o, slopes):
    B_, S_, _ = x.shape
    proj = x @ w_in
    offsets = []
    acc = 0
    for sz in IN_SIZES[:-1]:
        acc += sz
        offsets.append(acc)
    (b_g, c_g, xin, q, kc, vc, ks, vs, kw, vw, nsa_g, merge_g) = jnp.split(proj, offsets, axis=-1)

    conv_out = short_conv_mixer(b_g, c_g, xin, conv_w, w_conv_out)

    def to_groups(t):
        return t.reshape(B_, S_, N_KV_GROUPS, HEAD_DIM).transpose(0, 2, 1, 3)

    qh = q.reshape(B_, S_, N_KV_GROUPS, HEADS_PER_GROUP, HEAD_DIM).transpose(0, 2, 3, 1, 4)
    k_cmp = compress_blocks(to_groups(kc), cmp_pos[0], cmp_w1[0], cmp_b1[0], cmp_w2[0])
    v_cmp = compress_blocks(to_groups(vc), cmp_pos[1], cmp_w1[1], cmp_b1[1], cmp_w2[1])
    gates = jax.nn.sigmoid(nsa_g).reshape(B_, S_, N_KV_GROUPS, HEADS_PER_GROUP, 3).transpose(0, 2, 3, 1, 4)
    attn_out = nsa_attention(qh, k_cmp, v_cmp, to_groups(ks), to_groups(vs),
                             to_groups(kw), to_groups(vw), gates, slopes)

    g_conv, g_attn = jnp.split(jax.nn.sigmoid(merge_g), 2, axis=-1)
    return (g_conv * conv_out + g_attn * attn_out) @ w_o


def swiglu(x, w_ffn_in, w_ffn_out):
    a, u = jnp.split(x @ w_ffn_in, 2, axis=-1)
    return (jax.nn.silu(a) * u) @ w_ffn_out


def setup_inputs(seed: int = 0) -> dict:
    key = jax.random.key(seed)
    ks = jax.random.split(key, 15)

    def nrm(k, shape, scale):
        return scale * jax.random.normal(k, shape, jnp.float32)

    return {
        "x": nrm(ks[0], (BATCH, SEQ, D_MODEL), 1.0),
        "w_in": nrm(ks[1], (DEPTH, D_MODEL, N_IN), D_MODEL ** -0.5),
        "conv_w": nrm(ks[2], (DEPTH, CONV_K, CONV_WIDTH), CONV_K ** -0.5),
        "w_conv_out": nrm(ks[3], (DEPTH, CONV_WIDTH, D_MODEL), CONV_WIDTH ** -0.5),
        "cmp_pos": nrm(ks[4], (DEPTH, 2, CMP_BLOCK, HEAD_DIM), 0.02),
        "cmp_w1": nrm(ks[5], (DEPTH, 2, CMP_BLOCK * HEAD_DIM, CMP_HIDDEN), (CMP_BLOCK * HEAD_DIM) ** -0.5),
        "cmp_b1": nrm(ks[6], (DEPTH, 2, CMP_HIDDEN), 0.01),
        "cmp_w2": nrm(ks[7], (DEPTH, 2, CMP_HIDDEN, HEAD_DIM), CMP_HIDDEN ** -0.5),
        "w_o": nrm(ks[8], (DEPTH, D_MODEL, D_MODEL), BETA * D_MODEL ** -0.5),
        "ln1_g": 1.0 + nrm(ks[9], (DEPTH, D_MODEL), 0.02),
        "ln1_b": nrm(ks[10], (DEPTH, D_MODEL), 0.01),
        "w_ffn_in": nrm(ks[11], (DEPTH, D_MODEL, 2 * D_FF), D_MODEL ** -0.5),
        "w_ffn_out": nrm(ks[12], (DEPTH, D_FF, D_MODEL), BETA * D_FF ** -0.5),
        "ln2_g": 1.0 + nrm(ks[13], (DEPTH, D_MODEL), 0.02),
        "ln2_b": nrm(ks[14], (DEPTH, D_MODEL), 0.01),
    }


def reference(x, w_in, conv_w, w_conv_out, cmp_pos, cmp_w1, cmp_b1, cmp_w2, w_o,
              ln1_g, ln1_b, w_ffn_in, w_ffn_out, ln2_g, ln2_b):
    slopes = alibi_slopes()
    for l in range(DEPTH):
        mix = hybrid_mixer(x, w_in[l], conv_w[l], w_conv_out[l], cmp_pos[l], cmp_w1[l],
                           cmp_b1[l], cmp_w2[l], w_o[l], slopes)
        x = layer_norm(ALPHA * x + mix, ln1_g[l], ln1_b[l])
        x = layer_norm(ALPHA * x + swiglu(x, w_ffn_in[l], w_ffn_out[l]), ln2_g[l], ln2_b[l])
    return x
```

```cpp
#include <hip/hip_runtime.h>
#include <hip/hip_cooperative_groups.h>
#include <cstdio>
#include <cstdint>
namespace cg = cooperative_groups;

#ifndef PH_MASK
#define PH_MASK 0xFFFF
#endif
#ifndef REP_MASK
#define REP_MASK 0
#endif
#ifndef ONE_LAUNCH
#define ONE_LAUNCH 1
#endif

typedef __attribute__((ext_vector_type(8))) short bf16x8;
typedef __attribute__((ext_vector_type(4))) float f32x4;
typedef __attribute__((ext_vector_type(2))) __bf16 bf16v2;
typedef unsigned short u16;
typedef __attribute__((ext_vector_type(4))) unsigned u32x4;
typedef __attribute__((ext_vector_type(2))) unsigned u32x2;

constexpr int T_ = 32768, S_ = 8192, D_ = 1024, NIN = 6192, DFF = 2816;
constexpr int N1 = 4224;
constexpr float ALPHA = 1.4142135623730951f;
constexpr float LOG2E = 1.4426950408889634f;

constexpr size_t MiB = 1ull << 20;
constexpr size_t OFF_WIN = 0;
constexpr size_t OFF_WMG = OFF_WIN + 2ull * N1 * 1024 * 2;
constexpr size_t OFF_WCO = OFF_WMG + 2ull * 2048 * 1024 * 2;
constexpr size_t OFF_WO  = OFF_WCO + 2ull * 1024 * 512 * 2;
constexpr size_t OFF_WF1 = OFF_WO  + 2ull * 1024 * 1024 * 2;
constexpr size_t OFF_WF2 = OFF_WF1 + 2ull * 5632 * 1024 * 2;
constexpr size_t OFF_WC1 = OFF_WF2 + 2ull * 1024 * 2816 * 2;
constexpr size_t OFF_WC2 = OFF_WC1 + 4ull * 128 * 2048 * 2;
constexpr size_t OFF_PB  = OFF_WC2 + 4ull * 64 * 128 * 2;
constexpr size_t OFF_KCMP = OFF_PB + 4096;
constexpr size_t OFF_VCMP = OFF_KCMP + 16ull * 512 * 64 * 2;
constexpr size_t OFF_GATE = OFF_VCMP + 16ull * 512 * 64 * 2;
constexpr size_t OFF_XB   = OFF_GATE + (size_t)T_ * 48 * 4;
constexpr size_t OFF_BV   = OFF_XB + (size_t)T_ * 1024 * 2;
constexpr size_t OFF_BCX  = OFF_BV + (size_t)T_ * 512 * 2;
constexpr size_t OFF_Q    = OFF_BCX + (size_t)T_ * 1536 * 2;
constexpr size_t OFF_KCVC = OFF_Q + (size_t)T_ * 1024 * 2;
constexpr size_t OFF_KSW  = OFF_KCVC + (size_t)T_ * 512 * 2;
constexpr size_t OFF_VST  = OFF_KSW + (size_t)T_ * 512 * 2;
constexpr size_t OFF_VWT  = OFF_VST + 16ull * 64 * S_ * 2;
constexpr size_t OFF_STAT = OFF_VWT + 16ull * 64 * S_ * 2;
constexpr size_t OFF_BAR  = OFF_STAT + (size_t)T_ * 8;
constexpr size_t OFF_END  = OFF_BAR + 16384;
constexpr size_t OFF_ATT  = OFF_BCX;
constexpr size_t OFF_MRG  = OFF_Q;
constexpr size_t OFF_H    = OFF_BCX;
static_assert(OFF_BCX + (size_t)T_ * DFF * 2 <= OFF_END, "h alias");
static_assert(OFF_END <= 512 * MiB, "ws");

struct Params {
  const float *x, *w_in, *conv_w, *w_conv_out, *cmp_pos, *cmp_w1, *cmp_b1, *cmp_w2, *w_o,
      *ln1_g, *ln1_b, *w_ffn_in, *w_ffn_out, *ln2_g, *ln2_b;
  float* out;
  char* ws;
  int phase_begin, phase_end;
};

constexpr int SMEM_BYTES = 73728;
constexpr int NRM_WORD = 3700;

__device__ __forceinline__ int otid() { int t = threadIdx.x; asm volatile("" : "+v"(t)); return t; }
__device__ __forceinline__ char* optr(char* q) { size_t z = 0; asm volatile("" : "+s"(z)); return q + z; }
__device__ __forceinline__ unsigned pack2(float a, float b) {
  bf16v2 v; v[0] = (__bf16)a; v[1] = (__bf16)b;
  return *reinterpret_cast<unsigned*>(&v);
}
__device__ __forceinline__ u16 f2bf(float a) { __bf16 v = (__bf16)a; return *reinterpret_cast<u16*>(&v); }
__device__ __forceinline__ float bf2f(unsigned h) { return __uint_as_float(h << 16); }
__device__ __forceinline__ float bflo(unsigned u) { return __uint_as_float(u << 16); }
__device__ __forceinline__ float bfhi(unsigned u) { return __uint_as_float(u & 0xFFFF0000u); }
__device__ __forceinline__ float sigmoidf_(float x) { return __builtin_amdgcn_rcpf(1.f + __expf(-x)); }
__device__ __forceinline__ f32x4 mfma16(bf16x8 a, bf16x8 b, f32x4 c) {
  return __builtin_amdgcn_mfma_f32_16x16x32_bf16(a, b, c, 0, 0, 0);
}

struct GUnit {
  const u16* A; const u16* B;
  unsigned aoff[4], boff[4];
  int akstep, nkt, m0, n0, step;
};
struct GPre { u32x4 a0[4], b0[4], a1[4], b1[4]; };

__device__ __forceinline__ void gemm_issue(GPre& r, const GUnit& u) {
#pragma unroll
  for (int j = 0; j < 4; ++j) {
    r.a0[j] = *reinterpret_cast<const u32x4*>(u.A + u.aoff[j]);
    r.b0[j] = *reinterpret_cast<const u32x4*>(u.B + u.boff[j]);
  }
#pragma unroll
  for (int j = 0; j < 4; ++j) {
    r.a1[j] = *reinterpret_cast<const u32x4*>(u.A + u.aoff[j] + (size_t)u.akstep);
    r.b1[j] = *reinterpret_cast<const u32x4*>(u.B + u.boff[j] + 64);
  }
}

template <class Next>
__device__ __forceinline__ void gemm_run(GPre& r, const GUnit& u, f32x4 (&acc)[4][4], char* smem, Next next) {
  const int tid = otid(), lane = tid & 63, w = tid >> 6, l15 = lane & 15, g4 = lane >> 4;
  const int wr = w >> 1, wc = w & 1;
  const int st_off = (tid >> 3) * 128 + ((((tid & 7) ^ ((tid >> 3) & 7))) << 4);
  const int rb = tid >> 3;
  const int rbp = (((rb >> 2) & 1) << 4) | (((rb >> 4) & 1) << 3) | (((rb >> 3) & 1) << 2) | (rb & 3);
  const int stb_off = 16384 + rbp * 128 + ((((tid & 7) ^ (rbp & 7))) << 4);
  const u16* A = u.A; const u16* B = u.B;
  const int akstep = u.akstep, nkt = u.nkt;
#pragma unroll
  for (int i = 0; i < 4; ++i)
#pragma unroll
    for (int j = 0; j < 4; ++j) acc[i][j] = f32x4{0.f, 0.f, 0.f, 0.f};
  auto ld0 = [&](int kt) {
    const size_t ka = (size_t)kt * akstep, kb = (size_t)kt * 64;
#pragma unroll
    for (int j = 0; j < 4; ++j) {
      r.a0[j] = *reinterpret_cast<const u32x4*>(A + u.aoff[j] + ka);
      r.b0[j] = *reinterpret_cast<const u32x4*>(B + u.boff[j] + kb);
    }
  };
  auto ld1 = [&](int kt) {
    const size_t ka = (size_t)kt * akstep, kb = (size_t)kt * 64;
#pragma unroll
    for (int j = 0; j < 4; ++j) {
      r.a1[j] = *reinterpret_cast<const u32x4*>(A + u.aoff[j] + ka);
      r.b1[j] = *reinterpret_cast<const u32x4*>(B + u.boff[j] + kb);
    }
  };
  auto st0 = [&](char* dst) {
#pragma unroll
    for (int j = 0; j < 4; ++j) {
      *reinterpret_cast<u32x4*>(dst + st_off + j * 4096) = r.a0[j];
      *reinterpret_cast<u32x4*>(dst + stb_off + j * 4096) = r.b0[j];
    }
  };
  auto st1 = [&](char* dst) {
#pragma unroll
    for (int j = 0; j < 4; ++j) {
      *reinterpret_cast<u32x4*>(dst + st_off + j * 4096) = r.a1[j];
      *reinterpret_cast<u32x4*>(dst + stb_off + j * 4096) = r.b1[j];
    }
  };
  auto compute = [&](const char* As) {
    const char* Bs = As + 16384;
    bf16x8 af[2][4], bfr[2][4];
#pragma unroll
    for (int ks = 0; ks < 2; ++ks) {
      const int coff = (((ks * 4 + g4) ^ (l15 & 7)) << 4);
#pragma unroll
      for (int mt = 0; mt < 4; ++mt)
        af[ks][mt] = *reinterpret_cast<const bf16x8*>(As + (wr * 64 + mt * 16 + l15) * 128 + coff);
#pragma unroll
      for (int nt = 0; nt < 4; ++nt)
        bfr[ks][nt] = *reinterpret_cast<const bf16x8*>(Bs + (wc * 64 + nt * 16 + l15) * 128 + coff);
    }
#pragma unroll
    for (int ks = 0; ks < 2; ++ks)
#pragma unroll
      for (int mt = 0; mt < 4; ++mt)
#pragma unroll
        for (int nt = 0; nt < 4; ++nt) acc[mt][nt] = mfma16(bfr[ks][nt], af[ks][mt], acc[mt][nt]);
  };
#define SGB(mask, n) __builtin_amdgcn_sched_group_barrier(mask, n, 0)
#define SGB_LOADS() SGB(0x008, 1); SGB(0x020, 1); SGB(0x008, 1); SGB(0x100, 1);
#define SGB_WRITES() SGB(0x008, 1); SGB(0x200, 1); SGB(0x008, 1);
#define SCHED_TILE()                                                                              \
  SGB(0x100, 8);                                                                                  \
  SGB_LOADS() SGB_LOADS() SGB_LOADS() SGB_LOADS() SGB_LOADS() SGB_LOADS() SGB_LOADS() SGB_LOADS() \
  SGB_WRITES() SGB_WRITES() SGB_WRITES() SGB_WRITES() SGB_WRITES() SGB_WRITES() SGB_WRITES() SGB_WRITES()
  st0(smem);
  __syncthreads();
#pragma unroll 1
  for (int kt = 0; kt < nkt - 2; kt += 2) {
    __builtin_amdgcn_s_setprio(1);
    ld0(kt + 2);
    compute(smem);
    st1(smem + 32768);
    SCHED_TILE()
    __builtin_amdgcn_s_setprio(0);
    __syncthreads();
    __builtin_amdgcn_s_setprio(1);
    ld1(kt + 3);
    compute(smem + 32768);
    st0(smem);
    SCHED_TILE()
    __builtin_amdgcn_s_setprio(0);
    __syncthreads();
  }
  GUnit nu;
  next(nu);
  __builtin_amdgcn_s_setprio(1);
#pragma unroll
  for (int j = 0; j < 4; ++j) {
    r.a0[j] = *reinterpret_cast<const u32x4*>(nu.A + nu.aoff[j]);
    r.b0[j] = *reinterpret_cast<const u32x4*>(nu.B + nu.boff[j]);
  }
  compute(smem);
  st1(smem + 32768);
  SCHED_TILE()
  __builtin_amdgcn_s_setprio(0);
  __syncthreads();
  __builtin_amdgcn_s_setprio(1);
#pragma unroll
  for (int j = 0; j < 4; ++j) {
    r.a1[j] = *reinterpret_cast<const u32x4*>(nu.A + nu.aoff[j] + (size_t)nu.akstep);
    r.b1[j] = *reinterpret_cast<const u32x4*>(nu.B + nu.boff[j] + 64);
  }
  compute(smem + 32768);
  SGB(0x100, 8);
  SGB_LOADS() SGB_LOADS() SGB_LOADS() SGB_LOADS() SGB_LOADS() SGB_LOADS() SGB_LOADS() SGB_LOADS()
  __builtin_amdgcn_s_setprio(0);
  __syncthreads();
#undef SCHED_TILE
#undef SGB_WRITES
#undef SGB_LOADS
#undef SGB
}

__device__ __forceinline__ void std_offsets(unsigned (&off)[4], int r0, int ld) {
  const int tid = otid();
#pragma unroll
  for (int j = 0; j < 4; ++j) off[j] = (unsigned)(r0 + (tid >> 3) + 32 * j) * (unsigned)ld + (tid & 7) * 8;
}

template <int NSTEPS, class Setup, class Epi>
__device__ __forceinline__ void gemm_stream(int NT, Setup setup, Epi epi, char* smem) {
  const int xcd = blockIdx.x & 7, lb = blockIdx.x >> 3, nlb = gridDim.x >> 3, total = 32 * NT;
  int s = lb, step = 0;
  if (s >= total) return;
  GUnit cur;
  GPre pre;
  auto mk = [&](GUnit& u, int s_, int step_) {
    const int grp = s_ / (8 * NT), wv = s_ % (8 * NT);
    u.m0 = ((xcd * 4 + grp) * 8 + (wv & 7)) * 128;
    u.n0 = (wv >> 3) * 128;
    u.step = step_;
    setup(u);
  };
  mk(cur, s, 0);
  gemm_issue(pre, cur);
#pragma unroll 1
  while (true) {
    f32x4 acc[4][4];
    int ns = s, nstep = step + 1;
    if (nstep == NSTEPS) { nstep = 0; ns = s + nlb; }
    const bool has = ns < total;
    if (!has) { ns = s; nstep = step; }
    gemm_run(pre, cur, acc, smem, [&](GUnit& nu) { mk(nu, ns, nstep); });
    epi(cur, acc);
    if (!has) break;
    mk(cur, ns, nstep);
    s = ns; step = nstep;
  }
}

__device__ __forceinline__ void transpose_job(const float* __restrict__ src, int ld, int K, int N, int mode, u16* __restrict__ dst,
                              char* smem) {
  float* t = reinterpret_cast<float*>(smem);
  const int tid = otid(), tx = tid & 31, ty = tid >> 5;
  const int ntn = N / 32, ntk = K / 64;
  for (int tile = blockIdx.x; tile < ntn * ntk; tile += gridDim.x) {
    const int n0 = (tile % ntn) * 32, k0 = (tile / ntn) * 64;
    const int n = n0 + tx;
    int sc;
    if (mode == 0) sc = n;
    else if (mode == 1) sc = (n < 4144) ? n : -1;
    else if (mode == 2) sc = 4144 + n;
    else sc = ((n & 63) < 32) ? ((n >> 6) * 32 + (n & 63)) : (DFF + (n >> 6) * 32 + (n & 63) - 32);
#pragma unroll
    for (int i = 0; i < 8; ++i) {
      const int k = k0 + ty + 8 * i;
      t[(ty + 8 * i) * 33 + tx] = (sc >= 0) ? src[(size_t)k * ld + sc] : 0.f;
    }
    __syncthreads();
#pragma unroll
    for (int i = 0; i < 4; ++i) {
      const int nn = ty + 8 * i;
      const unsigned v = pack2(t[(2 * tx) * 33 + nn], t[(2 * tx + 1) * 33 + nn]);
      *reinterpret_cast<unsigned*>(dst + (size_t)(n0 + nn) * K + k0 + 2 * tx) = v;
    }
    __syncthreads();
  }
}

__device__ __forceinline__ void phase_prologue(const Params& p, char* smem) {
  char* ws = optr(p.ws);
  for (int l = 0; l < 2; ++l) {
    transpose_job(p.w_in + (size_t)l * D_ * NIN, NIN, 1024, N1, 1, (u16*)(ws + OFF_WIN) + (size_t)l * N1 * 1024, smem);
    transpose_job(p.w_in + (size_t)l * D_ * NIN, NIN, 1024, 2048, 2, (u16*)(ws + OFF_WMG) + (size_t)l * 2048 * 1024, smem);
    transpose_job(p.w_conv_out + (size_t)l * 512 * 1024, 1024, 512, 1024, 0, (u16*)(ws + OFF_WCO) + (size_t)l * 1024 * 512, smem);
    transpose_job(p.w_o + (size_t)l * 1024 * 1024, 1024, 1024, 1024, 0, (u16*)(ws + OFF_WO) + (size_t)l * 1024 * 1024, smem);
    transpose_job(p.w_ffn_in + (size_t)l * 1024 * 5632, 5632, 1024, 5632, 3, (u16*)(ws + OFF_WF1) + (size_t)l * 5632 * 1024, smem);
    transpose_job(p.w_ffn_out + (size_t)l * DFF * 1024, 1024, DFF, 1024, 0, (u16*)(ws + OFF_WF2) + (size_t)l * 1024 * DFF, smem);
    for (int kv = 0; kv < 2; ++kv) {
      transpose_job(p.cmp_w1 + (size_t)(l * 2 + kv) * 2048 * 128, 128, 2048, 128, 0, (u16*)(ws + OFF_WC1) + (size_t)(l * 2 + kv) * 128 * 2048, smem);
      transpose_job(p.cmp_w2 + (size_t)(l * 2 + kv) * 128 * 64, 64, 128, 64, 0, (u16*)(ws + OFF_WC2) + (size_t)(l * 2 + kv) * 64 * 128, smem);
    }
  }
  const int gtid = blockIdx.x * 256 + otid(), gsz = gridDim.x * 256;
  {
    u16* xb = (u16*)(ws + OFF_XB);
    for (size_t i = gtid; i < (size_t)T_ * D_ / 8; i += gsz) {
      const float4 a = reinterpret_cast<const float4*>(p.x)[2 * i], b = reinterpret_cast<const float4*>(p.x)[2 * i + 1];
      uint4 o; o.x = pack2(a.x, a.y); o.y = pack2(a.z, a.w); o.z = pack2(b.x, b.y); o.w = pack2(b.z, b.w);
      reinterpret_cast<uint4*>(xb)[i] = o;
    }
  }
  {
    const int gw = gtid >> 6, lane = otid() & 63;
    if (gw < 512) {
      const int lk = gw >> 7, n = gw & 127;
      const float* pos = p.cmp_pos + (size_t)lk * 2048;
      const float* w1 = p.cmp_w1 + (size_t)lk * 2048 * 128;
      float s = 0.f;
      for (int k = lane; k < 2048; k += 64) s += pos[k] * w1[(size_t)k * 128 + n];
      for (int o = 32; o > 0; o >>= 1) s += __shfl_xor(s, o);
      if (lane == 0) reinterpret_cast<float*>(ws + OFF_PB)[gw] = s + p.cmp_b1[lk * 128 + n];
    }
  }
  if (gtid < 16 * 64) {
    const int bg = gtid >> 6, d = gtid & 63;
    ((u16*)(ws + OFF_KCMP))[((size_t)bg * 512 + 511) * 64 + d] = 0;
    ((u16*)(ws + OFF_VCMP))[((size_t)bg * 64 + d) * 512 + 511] = 0;
  }
}

__device__ __forceinline__ void phase_gemm1(const Params& p, int l, char* smem) {
  char* ws = optr(p.ws);
  const u16* A = (const u16*)(ws + OFF_XB);
  const u16* B = (const u16*)(ws + OFF_WIN) + (size_t)l * N1 * 1024;
  const int tid = otid(), lane = tid & 63, w = tid >> 6, l15 = lane & 15, g4 = lane >> 4, wr = w >> 1, wc = w & 1;
  auto setup = [&](GUnit& u) {
    u.A = A; u.B = B; u.akstep = 64; u.nkt = 16;
    {
      const int t = u.n0 >> 7;
      const int lt = t < 2 ? 26 + t : t < 4 ? 28 + t : t < 30 ? t - 4 : t < 32 ? t - 2 : 32;
      u.n0 = lt * 128;
    }
    std_offsets(u.aoff, u.m0, 1024); std_offsets(u.boff, u.n0, 1024);
  };
  auto epi = [&](const GUnit& u, f32x4 (&acc)[4][4]) {
    const int m0 = u.m0, n0 = u.n0, nt_ = u.n0 >> 7;
    const int ntype = (nt_ >= 12 && nt_ < 20) ? 0 : (nt_ == 24 || nt_ == 25) ? 1 : (nt_ == 28 || nt_ == 29) ? 2 : -1;
    float wmax = 0.f;
#pragma unroll
    for (int mt = 0; mt < 4; ++mt) {
      const int m = m0 + wr * 64 + mt * 16 + l15;
      float rowsq = 0.f;
#pragma unroll
      for (int np = 0; np < 2; ++np) {
        const int n = n0 + wc * 64 + np * 32 + g4 * 8;
        const f32x4 v0 = acc[mt][2 * np], v1 = acc[mt][2 * np + 1];
        rowsq += v0[0] * v0[0] + v0[1] * v0[1] + v0[2] * v0[2] + v0[3] * v0[3] + v1[0] * v1[0] + v1[1] * v1[1] + v1[2] * v1[2] + v1[3] * v1[3];
        if (nt_ < 12) {
          u32x4 o; o[0] = pack2(v0[0], v0[1]); o[1] = pack2(v0[2], v0[3]); o[2] = pack2(v1[0], v1[1]); o[3] = pack2(v1[2], v1[3]);
          *reinterpret_cast<u32x4*>((u16*)(ws + OFF_BCX) + (size_t)m * 1536 + n) = o;
        } else if (nt_ < 20) {
          const float sc = 0.125f * LOG2E;
          u32x4 o; o[0] = pack2(v0[0] * sc, v0[1] * sc); o[1] = pack2(v0[2] * sc, v0[3] * sc);
          o[2] = pack2(v1[0] * sc, v1[1] * sc); o[3] = pack2(v1[2] * sc, v1[3] * sc);
          *reinterpret_cast<u32x4*>((u16*)(ws + OFF_Q) + (size_t)m * 1024 + (n - 1536)) = o;
        } else if (nt_ < 24) {
          u32x4 o; o[0] = pack2(v0[0], v0[1]); o[1] = pack2(v0[2], v0[3]); o[2] = pack2(v1[0], v1[1]); o[3] = pack2(v1[2], v1[3]);
          *reinterpret_cast<u32x4*>((u16*)(ws + OFF_KCVC) + (size_t)m * 512 + (n - 2560)) = o;
        } else if (nt_ < 26 || nt_ == 28 || nt_ == 29) {
          const int c = (nt_ < 26) ? (n - 3072) : (256 + n - 3584);
          u32x4 o; o[0] = pack2(v0[0], v0[1]); o[1] = pack2(v0[2], v0[3]); o[2] = pack2(v1[0], v1[1]); o[3] = pack2(v1[2], v1[3]);
          *reinterpret_cast<u32x4*>((u16*)(ws + OFF_KSW) + (size_t)m * 512 + c) = o;
        } else if (nt_ < 32) {
          const int c = (nt_ < 28) ? (n - 3328) : (n - 3840);
          u16* vt = (u16*)(ws + ((nt_ < 28) ? OFF_VST : OFF_VWT));
          const int b = m >> 13, sp = m & (S_ - 1), g = c >> 6, d = c & 63;
#pragma unroll
          for (int j = 0; j < 4; ++j) {
            vt[((size_t)((b * 4 + g) * 64 + d + j)) * S_ + sp] = f2bf(v0[j]);
            vt[((size_t)((b * 4 + g) * 64 + d + 4 + j)) * S_ + sp] = f2bf(v1[j]);
          }
        } else {
          const int c = n - 4096;
          if (c < 48) {
            float4 o; o.x = sigmoidf_(v0[0]); o.y = sigmoidf_(v0[1]); o.z = sigmoidf_(v0[2]); o.w = sigmoidf_(v0[3]);
            float4 o1; o1.x = sigmoidf_(v1[0]); o1.y = sigmoidf_(v1[1]); o1.z = sigmoidf_(v1[2]); o1.w = sigmoidf_(v1[3]);
            float* gp = (float*)(ws + OFF_GATE) + (size_t)m * 48 + c;
            *reinterpret_cast<float4*>(gp) = o;
            *reinterpret_cast<float4*>(gp + 4) = o1;
          }
        }
      }
      if (ntype >= 0) {
        rowsq += __shfl_xor(rowsq, 16);
        rowsq += __shfl_xor(rowsq, 32);
        wmax = fmaxf(wmax, rowsq);
      }
    }
    if (ntype >= 0) {
#pragma unroll
      for (int o = 1; o < 16; o <<= 1) wmax = fmaxf(wmax, __shfl_xor(wmax, o));
      if (ntype == 0) wmax *= (0.125f * LOG2E) * (0.125f * LOG2E);
      if (lane == 0) atomicMax((unsigned*)(ws + OFF_BAR) + NRM_WORD + l * 4 + ntype, __float_as_uint(wmax));
    }
  };
  gemm_stream<1>(33, setup, epi, smem);
}

__device__ __forceinline__ float gelu_tanh(float x) {
  const float u = 0.7978845608028654f * (x + 0.044715f * x * x * x);
  const float e = __expf(2.f * u);
  const float th = 1.f - 2.f / (e + 1.f);
  return 0.5f * x * (1.f + th);
}

__device__ __forceinline__ void compress_tile(const Params& p, int l, int kv, int mtile, char* smem) {
  char* ws = optr(p.ws);
  const int tid = otid(), lane = tid & 63, w = tid >> 6, l15 = lane & 15, g4 = lane >> 4, wr = w >> 1, wc = w & 1;
  const u16* A = (const u16*)(ws + OFF_KCVC);
  const u16* B = (const u16*)(ws + OFF_WC1) + (size_t)(l * 2 + kv) * 128 * 2048;
  unsigned aoff[4], boff[4];
#pragma unroll
  for (int j = 0; j < 4; ++j) {
    int r = mtile * 128 + (tid >> 3) + 32 * j;
    r = r < 8176 ? r : 8175;
    const int bg = r / 511, i = r - bg * 511;
    const int b = bg >> 2, g = bg & 3;
    aoff[j] = (unsigned)(b * S_ + 16 * i) * 512u + kv * 256 + g * 64 + (tid & 7) * 8;
  }
  std_offsets(boff, 0, 2048);
  f32x4 acc[4][4];
  {
    GUnit u; GPre pre;
    u.A = A; u.B = B; u.akstep = 512; u.nkt = 32; u.m0 = 0; u.n0 = 0; u.step = 0;
#pragma unroll
    for (int j = 0; j < 4; ++j) { u.aoff[j] = aoff[j]; u.boff[j] = boff[j]; }
    gemm_issue(pre, u);
    gemm_run(pre, u, acc, smem, [&](GUnit& nu) { nu = u; });
  }
  const float* pb = reinterpret_cast<const float*>(ws + OFF_PB) + (l * 2 + kv) * 128;
#pragma unroll
  for (int mt = 0; mt < 4; ++mt) {
    const int m = wr * 64 + mt * 16 + l15;
#pragma unroll
    for (int np = 0; np < 2; ++np) {
      const int n = wc * 64 + np * 32 + g4 * 8;
      const float4 b0 = *reinterpret_cast<const float4*>(pb + n);
      const float4 b1 = *reinterpret_cast<const float4*>(pb + n + 4);
      const f32x4 v0 = acc[mt][2 * np], v1 = acc[mt][2 * np + 1];
      u32x4 o;
      o[0] = pack2(gelu_tanh(v0[0] + b0.x), gelu_tanh(v0[1] + b0.y));
      o[1] = pack2(gelu_tanh(v0[2] + b0.z), gelu_tanh(v0[3] + b0.w));
      o[2] = pack2(gelu_tanh(v1[0] + b1.x), gelu_tanh(v1[1] + b1.y));
      o[3] = pack2(gelu_tanh(v1[2] + b1.z), gelu_tanh(v1[3] + b1.w));
      const int ch = n >> 3;
      *reinterpret_cast<u32x4*>(smem + m * 256 + (((ch ^ (m & 7))) << 4)) = o;
    }
  }
  __syncthreads();
  const u16* W2 = (const u16*)(ws + OFF_WC2) + (size_t)(l * 2 + kv) * 64 * 128;
  f32x4 a2[2][4];
#pragma unroll
  for (int i = 0; i < 2; ++i)
#pragma unroll
    for (int j = 0; j < 4; ++j) a2[i][j] = f32x4{0.f, 0.f, 0.f, 0.f};
#pragma unroll
  for (int ks = 0; ks < 4; ++ks) {
    bf16x8 af[2], bfr[4];
#pragma unroll
    for (int i = 0; i < 2; ++i) {
      const int m = w * 32 + i * 16 + l15;
      af[i] = *reinterpret_cast<const bf16x8*>(smem + m * 256 + ((((ks * 4 + g4) ^ (m & 7))) << 4));
    }
#pragma unroll
    for (int nt = 0; nt < 4; ++nt)
      bfr[nt] = *reinterpret_cast<const bf16x8*>(W2 + (nt * 16 + l15) * 128 + ks * 32 + g4 * 8);
#pragma unroll
    for (int i = 0; i < 2; ++i)
#pragma unroll
      for (int nt = 0; nt < 4; ++nt) a2[i][nt] = mfma16(bfr[nt], af[i], a2[i][nt]);
  }
  if (kv == 0) {
    float wmax = 0.f;
#pragma unroll
    for (int i = 0; i < 2; ++i) {
      const int r = mtile * 128 + w * 32 + i * 16 + l15;
      float rowsq = 0.f;
#pragma unroll
      for (int nt = 0; nt < 4; ++nt)
#pragma unroll
        for (int j = 0; j < 4; ++j) rowsq += a2[i][nt][j] * a2[i][nt][j];
      rowsq += __shfl_xor(rowsq, 16);
      rowsq += __shfl_xor(rowsq, 32);
      wmax = fmaxf(wmax, r < 8176 ? rowsq : 0.f);
    }
#pragma unroll
    for (int o = 1; o < 16; o <<= 1) wmax = fmaxf(wmax, __shfl_xor(wmax, o));
    if (lane == 0) atomicMax((unsigned*)(ws + OFF_BAR) + NRM_WORD + l * 4 + 3, __float_as_uint(wmax));
  }
#pragma unroll
  for (int i = 0; i < 2; ++i) {
    const int r = mtile * 128 + w * 32 + i * 16 + l15;
    if (r < 8176) {
      const int bg = r / 511, c = r - bg * 511;
#pragma unroll
      for (int nt = 0; nt < 4; ++nt) {
        const int d = nt * 16 + g4 * 4;
        if (kv == 0) {
          uint2 o; o.x = pack2(a2[i][nt][0], a2[i][nt][1]); o.y = pack2(a2[i][nt][2], a2[i][nt][3]);
          *reinterpret_cast<uint2*>((u16*)(ws + OFF_KCMP) + ((size_t)bg * 512 + c) * 64 + d) = o;
        } else {
#pragma unroll
          for (int j = 0; j < 4; ++j)
            ((u16*)(ws + OFF_VCMP))[((size_t)bg * 64 + d + j) * 512 + c] = f2bf(a2[i][nt][j]);
        }
      }
    }
  }
  __syncthreads();
}

__device__ __forceinline__ void phase_conv_compress(const Params& p, int l, char* smem) {
  char* ws = optr(p.ws);
  for (int t = blockIdx.x; t < 128; t += gridDim.x) compress_tile(p, l, t >> 6, t & 63, smem);
  const u16* bcx = (const u16*)(ws + OFF_BCX);
  u16* bv = (u16*)(ws + OFF_BV);
  const float* cw = p.conv_w + (size_t)l * 3 * 512;
  const int cb0 = (gridDim.x >= 256) ? 128 : 0;
  if ((int)blockIdx.x < cb0) return;
  for (size_t idx = (size_t)(blockIdx.x - cb0) * 256 + otid(); idx < (size_t)T_ * 64; idx += (size_t)(gridDim.x - cb0) * 256) {
    const int t = (int)(idx >> 6), c0 = (int)(idx & 63) * 8;
    const int s = t & (S_ - 1);
    float v[8];
#pragma unroll
    for (int i = 0; i < 8; ++i) v[i] = 0.f;
#pragma unroll
    for (int k = 0; k < 3; ++k) {
      const int dt = 2 - k;
      if (s - dt >= 0) {
        const uint4 cc = *reinterpret_cast<const uint4*>(bcx + (size_t)(t - dt) * 1536 + 512 + c0);
        const uint4 xx = *reinterpret_cast<const uint4*>(bcx + (size_t)(t - dt) * 1536 + 1024 + c0);
        const float4 w0 = *reinterpret_cast<const float4*>(cw + k * 512 + c0);
        const float4 w1 = *reinterpret_cast<const float4*>(cw + k * 512 + c0 + 4);
        v[0] += w0.x * bflo(cc.x) * bflo(xx.x); v[1] += w0.y * bfhi(cc.x) * bfhi(xx.x);
        v[2] += w0.z * bflo(cc.y) * bflo(xx.y); v[3] += w0.w * bfhi(cc.y) * bfhi(xx.y);
        v[4] += w1.x * bflo(cc.z) * bflo(xx.z); v[5] += w1.y * bfhi(cc.z) * bfhi(xx.z);
        v[6] += w1.z * bflo(cc.w) * bflo(xx.w); v[7] += w1.w * bfhi(cc.w) * bfhi(xx.w);
      }
    }
    const uint4 bb = *reinterpret_cast<const uint4*>(bcx + (size_t)t * 1536 + c0);
    uint4 o;
    o.x = pack2(v[0] * bflo(bb.x), v[1] * bfhi(bb.x));
    o.y = pack2(v[2] * bflo(bb.y), v[3] * bfhi(bb.y));
    o.z = pack2(v[4] * bflo(bb.z), v[5] * bfhi(bb.z));
    o.w = pack2(v[6] * bflo(bb.w), v[7] * bfhi(bb.w));
    *reinterpret_cast<uint4*>(bv + (size_t)t * 512 + c0) = o;
  }
}

constexpr int LDS_IMP = 32768;
constexpr int LDS_UNI = 32768 + 33024;
constexpr int LDS_CNT = LDS_UNI + 16;
constexpr int LDS_LIST = LDS_UNI + 32;

struct TileRegs { u32x4 k0, k1, v0, v1; };

__device__ __forceinline__ void attn_prefetch(TileRegs& r, const u16* Kb, size_t ldk, const u16* Vb, size_t ldv) {
  const int tid = otid();
  const int row = (tid >> 3), c = (tid & 7) * 8;
  r.k0 = *reinterpret_cast<const u32x4*>(Kb + row * ldk + c);
  r.k1 = *reinterpret_cast<const u32x4*>(Kb + (row + 32) * ldk + c);
  r.v0 = *reinterpret_cast<const u32x4*>(Vb + row * ldv + c);
  r.v1 = *reinterpret_cast<const u32x4*>(Vb + (row + 32) * ldv + c);
}
__device__ __forceinline__ void attn_stage(const TileRegs& r, char* buf) {
  const int tid = otid();
  const int off = (tid >> 3) * 128 + ((((tid & 7) ^ ((tid >> 3) & 7))) << 4);
  *reinterpret_cast<u32x4*>(buf + off) = r.k0;
  *reinterpret_cast<u32x4*>(buf + off + 4096) = r.k1;
  *reinterpret_cast<u32x4*>(buf + 8192 + off) = r.v0;
  *reinterpret_cast<u32x4*>(buf + 8192 + off + 4096) = r.v1;
}

template <int MODE, bool MASKED, bool SELECT>
__device__ __forceinline__ void attn_tile(const char* buf, const bf16x8 (&qf)[2][2], f32x4 (&O)[2][4], float (&lsum)[2],
                                          const float (&invl)[2], const float (&slope)[2], float x0, float stride,
                                          float wlimit, bool selected, float* impq, bool impacc,
                                          float& p3carry) {
  const int lane = otid() & 63, l15 = lane & 15, g4 = lane >> 4;
  f32x4 psum[4];
#pragma unroll
  for (int i = 0; i < 4; ++i) psum[i] = f32x4{0.f, 0.f, 0.f, 0.f};
  const char* Kl = buf;
  const char* Vl = buf + 8192;
  float e[4];
#pragma unroll
  for (int j = 0; j < 4; ++j) e[j] = stride * (float)(g4 * 4 + j);
  bf16x8 pf[2][2];
  {
    bf16x8 kf[4][2];
#pragma unroll
    for (int sub = 0; sub < 4; ++sub)
#pragma unroll
      for (int ks = 0; ks < 2; ++ks)
        kf[sub][ks] = *reinterpret_cast<const bf16x8*>(Kl + (sub * 16 + l15) * 128 + ((((ks * 4 + g4) ^ (l15 & 7))) << 4));
#pragma unroll
    for (int hh = 0; hh < 2; ++hh) {
      f32x4 s[4];
#pragma unroll
      for (int sub = 0; sub < 4; ++sub) {
        float xs = x0 + stride * 16.f * (float)sub;
        if (SELECT) xs = selected ? xs : -1e32f;
        f32x4 bias;
#pragma unroll
        for (int j = 0; j < 4; ++j) bias[j] = slope[hh] * (xs + e[j]);
        __builtin_amdgcn_s_setprio(1);
        s[sub] = mfma16(kf[sub][0], qf[hh][0], bias);
        s[sub] = mfma16(kf[sub][1], qf[hh][1], s[sub]);
        __builtin_amdgcn_s_setprio(0);
      }
      float ls = 0.f;
#pragma unroll
      for (int sub = 0; sub < 4; ++sub) {
        const float xs = x0 + stride * 16.f * (float)sub;
#pragma unroll
        for (int j = 0; j < 4; ++j) {
          float pv = __builtin_amdgcn_exp2f(s[sub][j]);
          if (MASKED) { const float dd = xs + e[j]; pv = (dd <= 0.f && dd > -wlimit) ? pv : 0.f; }
          if (MODE == 1) { pv *= invl[hh]; psum[sub][j] += pv; }
          else ls += pv;
          s[sub][j] = pv;
        }
      }
      if (MODE != 1) lsum[hh] += ls;
      if (MODE != 0) {
#pragma unroll
        for (int kk = 0; kk < 2; ++kk) {
          union { bf16x8 v; unsigned u[4]; } pk;
          pk.u[0] = pack2(s[2 * kk][0], s[2 * kk][1]);
          pk.u[1] = pack2(s[2 * kk][2], s[2 * kk][3]);
          pk.u[2] = pack2(s[2 * kk + 1][0], s[2 * kk + 1][1]);
          pk.u[3] = pack2(s[2 * kk + 1][2], s[2 * kk + 1][3]);
          pf[hh][kk] = pk.v;
        }
      }
    }
  }
  if (MODE != 0) {
#pragma unroll
    for (int dt = 0; dt < 4; ++dt) {
      const int d = dt * 16 + l15;
      bf16x8 vf[2];
#pragma unroll
      for (int kk = 0; kk < 2; ++kk) {
        union { bf16x8 v; uint2 u[2]; } vv;
        const int c0 = kk * 4 + (g4 >> 1);
        vv.u[0] = *reinterpret_cast<const uint2*>(Vl + d * 128 + (((c0 ^ (d & 7))) << 4) + (g4 & 1) * 8);
        vv.u[1] = *reinterpret_cast<const uint2*>(Vl + d * 128 + ((((c0 + 2) ^ (d & 7))) << 4) + (g4 & 1) * 8);
        vf[kk] = vv.v;
      }
      __builtin_amdgcn_s_setprio(1);
#pragma unroll
      for (int hh = 0; hh < 2; ++hh) {
        O[hh][dt] = mfma16(vf[0], pf[hh][0], O[hh][dt]);
        O[hh][dt] = mfma16(vf[1], pf[hh][1], O[hh][dt]);
      }
      __builtin_amdgcn_s_setprio(0);
    }
  }
  if (MODE == 1) {
    float prev3 = p3carry;
#pragma unroll
    for (int sub = 0; sub < 4; ++sub) {
      const float give = (g4 == 3) ? prev3 : psum[sub][3];
      const float carry = __shfl(give, (lane + 48) & 63);
      float* dst = impq + sub * 4 + g4;
      const float base = impacc ? *dst : 0.f;
      *dst = base + (psum[sub][0] + psum[sub][1] + psum[sub][2] + psum[sub][3] + carry);
      prev3 = psum[sub][3];
    }
    p3carry = prev3;
  }
}

__device__ __forceinline__ float red4(float v) {
  v += __shfl_xor(v, 16);
  v += __shfl_xor(v, 32);
  return v;
}

__device__ __forceinline__ void attn_item(const Params& p, int l, int b, int g, int qt, char* smem) {
  char* ws = optr(p.ws);
  const int tid = otid(), lane = tid & 63, w = tid >> 6, l15 = lane & 15, g4 = lane >> 4;
  const int q0 = qt * 64, ql = w * 16 + l15, tq = q0 + ql;
  const int bg = b * 4 + g;
  const u16* qb = (const u16*)(ws + OFF_Q);
  const u16* ksw = (const u16*)(ws + OFF_KSW);
  const u16* kcmp = (const u16*)(ws + OFF_KCMP) + (size_t)bg * 512 * 64;
  const u16* vcmp = (const u16*)(ws + OFF_VCMP) + (size_t)bg * 64 * 512;
  const u16* vst = (const u16*)(ws + OFF_VST) + (size_t)bg * 64 * S_;
  const u16* vwt = (const u16*)(ws + OFF_VWT) + (size_t)bg * 64 * S_;
  const float* gate = (const float*)(ws + OFF_GATE) + (size_t)(b * S_ + tq) * 48 + g * 12;
  u16* ao = (u16*)(ws + OFF_ATT) + (size_t)(b * S_ + tq) * 1024 + g * 256;
  float* imp = reinterpret_cast<float*>(smem + LDS_IMP);
  unsigned* uni = reinterpret_cast<unsigned*>(smem + LDS_UNI);
  int* cntp = reinterpret_cast<int*>(smem + LDS_CNT);
  int* list = reinterpret_cast<int*>(smem + LDS_LIST);

  bf16x8 qf[2][2];
  float slope[2], lsum[2], invl[2];
  f32x4 O[2][4];
  if (tid < 4) uni[tid] = 0u;
  for (int i = tid; i < 64 * 129; i += 256) imp[i] = 0.f;

  const int nct = (4 * qt + 3 + 63) >> 6;
  const int kb0 = qt >= 8 ? qt - 8 : 0;
  float sm_c, sm_w, sm_s;
  {
    unsigned* nw = (unsigned*)(ws + OFF_BAR) + NRM_WORD + l * 4;
    const float qn = sqrtf(__uint_as_float(__hip_atomic_load(nw + 0, __ATOMIC_RELAXED, __HIP_MEMORY_SCOPE_AGENT)));
    const float ksn = sqrtf(__uint_as_float(__hip_atomic_load(nw + 1, __ATOMIC_RELAXED, __HIP_MEMORY_SCOPE_AGENT)));
    const float kwn = sqrtf(__uint_as_float(__hip_atomic_load(nw + 2, __ATOMIC_RELAXED, __HIP_MEMORY_SCOPE_AGENT)));
    const float kcn = sqrtf(__uint_as_float(__hip_atomic_load(nw + 3, __ATOMIC_RELAXED, __HIP_MEMORY_SCOPE_AGENT)));
    sm_c = 152.f + 1.05f * qn * kcn; sm_w = 152.f + 1.05f * qn * kwn; sm_s = 152.f + 1.05f * qn * ksn;
  }
  int ct0 = 0, ncp = nct, kbs = kb0, nA = 2 * nct + (qt - kb0 + 1);
  auto set_cut = [&](float slope_min) {
    const float inv = 1.f / slope_min;
    const float xc = ((float)q0 - 1039.f - sm_c * inv) * (1.f / 1024.f);
    ct0 = xc > 0.f ? (int)ceilf(xc) : 0;
    ct0 = ct0 < nct - 1 ? ct0 : nct - 1;
    ncp = nct - ct0;
    const float xw = ((float)q0 - 63.f - sm_w * inv) * (1.f / 64.f);
    kbs = xw > 0.f ? (int)ceilf(xw) : 0;
    kbs = kbs > kb0 ? kbs : kb0;
    kbs = kbs < qt ? kbs : qt;
    nA = 2 * ncp + (qt - kbs + 1);
  };

  auto load_q = [&](int hp) {
#pragma unroll
    for (int hh = 0; hh < 2; ++hh) {
      const int h = hp * 2 + hh;
#pragma unroll
      for (int ks = 0; ks < 2; ++ks)
        qf[hh][ks] = *reinterpret_cast<const bf16x8*>(qb + (size_t)(b * S_ + tq) * 1024 + (g * 4 + h) * 64 + ks * 32 + g4 * 8);
      slope[hh] = exp2f(-0.5f * (float)(g * 4 + h + 1)) * LOG2E;
      lsum[hh] = 0.f; invl[hh] = 0.f;
#pragma unroll
      for (int dt = 0; dt < 4; ++dt) O[hh][dt] = f32x4{0.f, 0.f, 0.f, 0.f};
    }
  };
  auto srcA = [&](int e, const u16*& Kb, size_t& ldk, const u16*& Vb, size_t& ldv) {
    if (e < 2 * ncp) {
      const int ct = ct0 + (e < ncp ? e : e - ncp);
      Kb = kcmp + (size_t)ct * 64 * 64; ldk = 64; Vb = vcmp + ct * 64; ldv = 512;
    } else {
      const int pos0 = (kbs + e - 2 * ncp) * 64;
      Kb = ksw + (size_t)(b * S_ + pos0) * 512 + 256 + g * 64; ldk = 512; Vb = vwt + pos0; ldv = S_;
    }
  };
  auto fold = [&](int hp, int br) {
#pragma unroll
    for (int hh = 0; hh < 2; ++hh) {
      const int h = hp * 2 + hh;
      float sc = gate[h * 3 + br];
      if (br != 0) { const float l = red4(lsum[hh]); sc *= (l > 0.f) ? 1.f / l : 0.f; }
#pragma unroll
      for (int dt = 0; dt < 4; ++dt) {
        uint2* dst = reinterpret_cast<uint2*>(ao + h * 64 + dt * 16 + g4 * 4);
        uint2 old; old.x = 0u; old.y = 0u;
        if (br != 0) old = *dst;
        const float a0 = bflo(old.x) + sc * O[hh][dt][0], a1 = bfhi(old.x) + sc * O[hh][dt][1];
        const float a2 = bflo(old.y) + sc * O[hh][dt][2], a3 = bfhi(old.y) + sc * O[hh][dt][3];
        uint2 o; o.x = pack2(a0, a1); o.y = pack2(a2, a3);
        *dst = o;
        O[hh][dt] = f32x4{0.f, 0.f, 0.f, 0.f};
      }
      lsum[hh] = 0.f;
    }
  };

  TileRegs tr;
#pragma unroll 1
  for (int hp = 0; hp < 2; ++hp) {
    load_q(hp);
    set_cut(slope[1]);
    float p3carry = 0.f;
    {
      const u16 *Kb, *Vb; size_t ldk, ldv;
      srcA(0, Kb, ldk, Vb, ldv);
      attn_prefetch(tr, Kb, ldk, Vb, ldv);
    }
#pragma unroll 1
    for (int e = 0; e < nA; ++e) {
      char* buf = smem + (e & 1) * 16384;
      attn_stage(tr, buf);
      __syncthreads();
      if (e + 1 < nA) {
        const u16 *Kb, *Vb; size_t ldk, ldv;
        srcA(e + 1, Kb, ldk, Vb, ldv);
        attn_prefetch(tr, Kb, ldk, Vb, ldv);
      }
      if (e < ncp) {
        attn_tile<0, true, false>(buf, qf, O, lsum, invl, slope, (float)((ct0 + e) * 1024 + 31 - tq), 16.f, 1e9f, true, imp, false, p3carry);
      } else if (e < 2 * ncp) {
        const int ct = ct0 + e - ncp;
        if (e == ncp) {
#pragma unroll
          for (int hh = 0; hh < 2; ++hh) { const float l = red4(lsum[hh]); invl[hh] = (l > 0.f) ? 1.f / l : 0.f; lsum[hh] = 0.f; }
          p3carry = 0.f;
        }
        attn_tile<1, true, false>(buf, qf, O, lsum, invl, slope, (float)(ct * 1024 + 31 - tq), 16.f, 1e9f, true,
                     imp + ql * 129 + ct * 16, true, p3carry);
      } else {
        if (e == 2 * ncp) fold(hp, 0);
        const int kb = kbs + e - 2 * ncp;
        const bool mk = (kb == qt) || (kb == qt - 8);
        if (mk) attn_tile<2, true, false>(buf, qf, O, lsum, invl, slope, (float)(kb * 64 - tq), 1.f, 512.f, true, imp, false, p3carry);
        else attn_tile<2, false, false>(buf, qf, O, lsum, invl, slope, (float)(kb * 64 - tq), 1.f, 512.f, true, imp, false, p3carry);
      }
    }
    fold(hp, 2);
    __syncthreads();
  }

  unsigned sel[4] = {0u, 0u, 0u, 0u};
  {
    unsigned key[32];
#pragma unroll
    for (int i = 0; i < 32; ++i) {
      const int j = g4 * 32 + i;
      const unsigned bits = __float_as_uint(imp[ql * 129 + j]);
      unsigned k = ((((bits >> 7) + 1u) << 7) & 0x7FFFFF80u) | (unsigned)(127 - j);
      if (j == 0 || j == qt || j == qt - 1) k = 0x80000000u | (unsigned)(127 - j);
      if (j > qt) k = 0u;
      key[i] = k;
    }
#pragma unroll 1
    for (int r = 0; r < 16; ++r) {
      unsigned m = 0u;
#pragma unroll
      for (int i = 0; i < 32; ++i) m = key[i] > m ? key[i] : m;
      unsigned o = __shfl_xor(m, 16); m = o > m ? o : m;
      o = __shfl_xor(m, 32); m = o > m ? o : m;
      if (m != 0u) {
        const int jw = 127 - (int)(m & 127u);
#pragma unroll
        for (int wi = 0; wi < 4; ++wi) sel[wi] |= ((jw >> 5) == wi) ? (1u << (jw & 31)) : 0u;
#pragma unroll
        for (int i = 0; i < 32; ++i) key[i] = (key[i] == m) ? 0u : key[i];
      }
    }
  }
  if (g4 == 0) {
#pragma unroll
    for (int wi = 0; wi < 4; ++wi) atomicOr(&uni[wi], sel[wi]);
  }
  __syncthreads();
  {
    const unsigned u0 = uni[0], u1 = uni[1], u2 = uni[2], u3 = uni[3];
    if (tid < 128) {
      const int j = tid, wi = j >> 5;
      const unsigned wv = wi == 0 ? u0 : wi == 1 ? u1 : wi == 2 ? u2 : u3;
      if ((wv >> (j & 31)) & 1u) {
        int pos = __popc(wv & ((1u << (j & 31)) - 1u));
        pos += (wi > 0 ? __popc(u0) : 0) + (wi > 1 ? __popc(u1) : 0) + (wi > 2 ? __popc(u2) : 0);
        list[pos] = j;
      }
    }
    if (tid == 0) *cntp = __popc(u0) + __popc(u1) + __popc(u2) + __popc(u3);
  }
  __syncthreads();
  const int nB = *cntp;

  float p3c2 = 0.f;
#pragma unroll 1
  for (int hp = 0; hp < 2; ++hp) {
    load_q(hp);
    int e0 = 0;
    {
      const float xs = ((float)q0 - 63.f - sm_s / slope[1]) * (1.f / 64.f);
      const int jmin = xs > 0.f ? (int)ceilf(xs) : 0;
      while (e0 < nB - 1 && list[e0] < jmin) ++e0;
    }
    {
      const int j0 = list[e0];
      attn_prefetch(tr, ksw + (size_t)(b * S_ + j0 * 64) * 512 + g * 64, 512, vst + j0 * 64, S_);
    }
#pragma unroll 1
    for (int e = e0; e < nB; ++e) {
      char* buf = smem + (e & 1) * 16384;
      const int j = list[e];
      attn_stage(tr, buf);
      __syncthreads();
      if (e + 1 < nB) {
        const int jn = list[e + 1];
        attn_prefetch(tr, ksw + (size_t)(b * S_ + jn * 64) * 512 + g * 64, 512, vst + jn * 64, S_);
      }
      const unsigned wsel = (j < 32) ? sel[0] : (j < 64) ? sel[1] : (j < 96) ? sel[2] : sel[3];
      const bool sl = (wsel >> (j & 31)) & 1u;
      if (j == qt) attn_tile<2, true, true>(buf, qf, O, lsum, invl, slope, (float)(j * 64 - tq), 1.f, 1e9f, sl, imp, false, p3c2);
      else attn_tile<2, false, true>(buf, qf, O, lsum, invl, slope, (float)(j * 64 - tq), 1.f, 1e9f, sl, imp, false, p3c2);
    }
    fold(hp, 1);
    __syncthreads();
  }
}

__device__ __forceinline__ void phase_attention(const Params& p, int l, char* smem) {
  unsigned* ctr = (unsigned*)(p.ws + OFF_BAR) + 3600 + 64 * l;
  int* slot = reinterpret_cast<int*>(smem + LDS_CNT + 8);
  const int tid = otid();
#pragma unroll 1
  for (;;) {
    if (tid == 0) *slot = (int)atomicAdd(ctr, 1u);
    __syncthreads();
    const int idx = *slot;
    __syncthreads();
    if (idx >= 2048) break;
    const int qt = 127 - (idx >> 4), g = 3 - ((idx >> 2) & 3), b = idx & 3;
    attn_item(p, l, b, g, qt, smem);
  }
}

__device__ __forceinline__ void phase_merge(const Params& p, int l, char* smem) {
  char* ws = optr(p.ws);
  const u16* xb = (const u16*)(ws + OFF_XB);
  const u16* bv = (const u16*)(ws + OFF_BV);
  const u16* att = (const u16*)(ws + OFF_ATT);
  const u16* wco = (const u16*)(ws + OFF_WCO) + (size_t)l * 1024 * 512;
  const u16* wmg = (const u16*)(ws + OFF_WMG) + (size_t)l * 2048 * 1024;
  u16* mrg = (u16*)(ws + OFF_MRG);
  const int tid = otid(), lane = tid & 63, w = tid >> 6, l15 = lane & 15, g4 = lane >> 4, wr = w >> 1, wc = w & 1;
  auto setup = [&](GUnit& u) {
    if (u.step == 0) {
      u.A = bv; u.B = wco; u.akstep = 64; u.nkt = 8;
      std_offsets(u.aoff, u.m0, 512); std_offsets(u.boff, u.n0, 512);
    } else {
      u.A = xb; u.B = wmg; u.akstep = 64; u.nkt = 16;
      std_offsets(u.aoff, u.m0, 1024); std_offsets(u.boff, (u.step - 1) * 1024 + u.n0, 1024);
    }
  };
  auto epi = [&](const GUnit& u, f32x4 (&acc)[4][4]) {
    const int m0 = u.m0, n0 = u.n0, step = u.step;
#pragma unroll
    for (int mt = 0; mt < 4; ++mt) {
      const int m = m0 + wr * 64 + mt * 16 + l15;
#pragma unroll
      for (int np = 0; np < 2; ++np) {
        const int n = n0 + wc * 64 + np * 32 + g4 * 8;
        u32x4* dst = reinterpret_cast<u32x4*>(mrg + (size_t)m * 1024 + n);
        float r[8];
#pragma unroll
        for (int j = 0; j < 4; ++j) { r[j] = acc[mt][2 * np][j]; r[4 + j] = acc[mt][2 * np + 1][j]; }
        if (step == 1) {
          const u32x4 o = *dst;
#pragma unroll
          for (int q = 0; q < 4; ++q) { r[2 * q] = sigmoidf_(r[2 * q]) * bflo(o[q]); r[2 * q + 1] = sigmoidf_(r[2 * q + 1]) * bfhi(o[q]); }
        } else if (step == 2) {
          const u32x4 o = *dst;
          const u32x4 a = *reinterpret_cast<const u32x4*>(att + (size_t)m * 1024 + n);
#pragma unroll
          for (int q = 0; q < 4; ++q) {
            r[2 * q] = bflo(o[q]) + sigmoidf_(r[2 * q]) * bflo(a[q]);
            r[2 * q + 1] = bfhi(o[q]) + sigmoidf_(r[2 * q + 1]) * bfhi(a[q]);
          }
        }
        u32x4 o2; o2[0] = pack2(r[0], r[1]); o2[1] = pack2(r[2], r[3]); o2[2] = pack2(r[4], r[5]); o2[3] = pack2(r[6], r[7]);
        *dst = o2;
      }
    }
  };
  gemm_stream<3>(8, setup, epi, smem);
}

__device__ __forceinline__ void phase_resgemm(const Params& p, const u16* A, int K, const u16* Bt, const float* resid,
                                              const float* pg, const float* pb, char* smem) {
  const float2* stat = (const float2*)(optr(p.ws) + OFF_STAT);
  float* out = p.out;
  const int tid = otid(), lane = tid & 63, w = tid >> 6, l15 = lane & 15, g4 = lane >> 4, wr = w >> 1, wc = w & 1;
  auto setup = [&](GUnit& u) {
    u.A = A; u.B = Bt; u.akstep = 64; u.nkt = K / 64;
    std_offsets(u.aoff, u.m0, K); std_offsets(u.boff, u.n0, K);
  };
  auto epi = [&](const GUnit& u, f32x4 (&acc)[4][4]) {
    const int m0 = u.m0, n0 = u.n0;
#pragma unroll
    for (int mt = 0; mt < 4; ++mt) {
      const int m = m0 + wr * 64 + mt * 16 + l15;
#pragma unroll
      for (int nt = 0; nt < 4; ++nt) {
        const int n = n0 + wc * 64 + (nt >> 1) * 32 + g4 * 8 + (nt & 1) * 4;
        float4 r;
        if (resid) {
          r = *reinterpret_cast<const float4*>(resid + (size_t)m * 1024 + n);
        } else {
          const float4 y = *reinterpret_cast<const float4*>(out + (size_t)m * 1024 + n);
          const float2 st = stat[m];
          const float4 gg = *reinterpret_cast<const float4*>(pg + n);
          const float4 bb = *reinterpret_cast<const float4*>(pb + n);
          r.x = (y.x - st.x) * st.y * gg.x + bb.x; r.y = (y.y - st.x) * st.y * gg.y + bb.y;
          r.z = (y.z - st.x) * st.y * gg.z + bb.z; r.w = (y.w - st.x) * st.y * gg.w + bb.w;
        }
        float4 o;
        o.x = ALPHA * r.x + acc[mt][nt][0]; o.y = ALPHA * r.y + acc[mt][nt][1];
        o.z = ALPHA * r.z + acc[mt][nt][2]; o.w = ALPHA * r.w + acc[mt][nt][3];
        *reinterpret_cast<float4*>(out + (size_t)m * 1024 + n) = o;
      }
    }
  };
  gemm_stream<1>(8, setup, epi, smem);
}

__device__ __forceinline__ void phase_ln(const Params& p, const float* gam, const float* bet, bool write_f32) {
  float* out = p.out;
  u16* xb = (u16*)(p.ws + OFF_XB);
  float2* stat = (float2*)(p.ws + OFF_STAT);
  const int lane = otid() & 63;
  const int gw = (blockIdx.x * 256 + otid()) >> 6, nw = gridDim.x * 4;
#pragma unroll 1
  for (int row0 = gw; row0 < T_; row0 += 2 * nw) {
    const int row1 = row0 + nw;
    const bool has1 = row1 < T_;
    const float* r0p = out + (size_t)row0 * 1024 + lane * 4;
    const float* r1p = out + (size_t)(has1 ? row1 : row0) * 1024 + lane * 4;
    f32x4 a0 = *reinterpret_cast<const f32x4*>(r0p), a1 = *reinterpret_cast<const f32x4*>(r0p + 256);
    f32x4 a2 = *reinterpret_cast<const f32x4*>(r0p + 512), a3 = *reinterpret_cast<const f32x4*>(r0p + 768);
    f32x4 b0 = *reinterpret_cast<const f32x4*>(r1p), b1 = *reinterpret_cast<const f32x4*>(r1p + 256);
    f32x4 b2 = *reinterpret_cast<const f32x4*>(r1p + 512), b3 = *reinterpret_cast<const f32x4*>(r1p + 768);
    f32x4 ta = a0 + a1 + a2 + a3, tb = b0 + b1 + b2 + b3;
    float sa = ta[0] + ta[1] + ta[2] + ta[3], sb = tb[0] + tb[1] + tb[2] + tb[3];
    for (int o = 32; o > 0; o >>= 1) { sa += __shfl_xor(sa, o); sb += __shfl_xor(sb, o); }
    const float mua = sa * (1.f / 1024.f), mub = sb * (1.f / 1024.f);
    a0 -= mua; a1 -= mua; a2 -= mua; a3 -= mua;
    b0 -= mub; b1 -= mub; b2 -= mub; b3 -= mub;
    ta = a0 * a0 + a1 * a1 + a2 * a2 + a3 * a3; tb = b0 * b0 + b1 * b1 + b2 * b2 + b3 * b3;
    float qa = ta[0] + ta[1] + ta[2] + ta[3], qb = tb[0] + tb[1] + tb[2] + tb[3];
    for (int o = 32; o > 0; o >>= 1) { qa += __shfl_xor(qa, o); qb += __shfl_xor(qb, o); }
    const float rsa = rsqrtf(qa * (1.f / 1024.f) + 1e-5f), rsb = rsqrtf(qb * (1.f / 1024.f) + 1e-5f);
    if (!write_f32 && lane == 0) {
      stat[row0] = make_float2(mua, rsa);
      if (has1) stat[row1] = make_float2(mub, rsb);
    }
#define LN_OUT(V, RS, ROW, C)                                                                       \
    {                                                                                               \
      const f32x4 gg = *reinterpret_cast<const f32x4*>(gam + (C) + lane * 4);                       \
      const f32x4 bb = *reinterpret_cast<const f32x4*>(bet + (C) + lane * 4);                       \
      const f32x4 o = V * RS * gg + bb;                                                             \
      if (write_f32) *reinterpret_cast<f32x4*>(out + (size_t)(ROW) * 1024 + (C) + lane * 4) = o;    \
      u32x2 ob; ob[0] = pack2(o[0], o[1]); ob[1] = pack2(o[2], o[3]);                               \
      *reinterpret_cast<u32x2*>(xb + (size_t)(ROW) * 1024 + (C) + lane * 4) = ob;                   \
    }
    LN_OUT(a0, rsa, row0, 0) LN_OUT(a1, rsa, row0, 256) LN_OUT(a2, rsa, row0, 512) LN_OUT(a3, rsa, row0, 768)
    if (has1) { LN_OUT(b0, rsb, row1, 0) LN_OUT(b1, rsb, row1, 256) LN_OUT(b2, rsb, row1, 512) LN_OUT(b3, rsb, row1, 768) }
#undef LN_OUT
  }
}

__device__ __forceinline__ void phase_ffn1(const Params& p, int l, char* smem) {
  char* ws = optr(p.ws);
  const u16* A = (const u16*)(ws + OFF_XB);
  const u16* B = (const u16*)(ws + OFF_WF1) + (size_t)l * 5632 * 1024;
  u16* hb = (u16*)(ws + OFF_H);
  const int tid = otid(), lane = tid & 63, w = tid >> 6, l15 = lane & 15, g4 = lane >> 4, wr = w >> 1, wc = w & 1;
  auto setup = [&](GUnit& u) {
    u.A = A; u.B = B; u.akstep = 64; u.nkt = 16;
    std_offsets(u.aoff, u.m0, 1024); std_offsets(u.boff, u.n0, 1024);
  };
  auto epi = [&](const GUnit& u, f32x4 (&acc)[4][4]) {
    const int m0 = u.m0, nt_ = u.n0 >> 7;
#pragma unroll
    for (int mt = 0; mt < 4; ++mt) {
      const int m = m0 + wr * 64 + mt * 16 + l15;
      float hv[8];
#pragma unroll
      for (int q = 0; q < 2; ++q)
#pragma unroll
        for (int j = 0; j < 4; ++j) {
          const float a = acc[mt][q][j], uu = acc[mt][q + 2][j];
          hv[q * 4 + j] = a * sigmoidf_(a) * uu;
        }
      u32x4 o; o[0] = pack2(hv[0], hv[1]); o[1] = pack2(hv[2], hv[3]); o[2] = pack2(hv[4], hv[5]); o[3] = pack2(hv[6], hv[7]);
      *reinterpret_cast<u32x4*>(hb + (size_t)m * DFF + (nt_ * 2 + wc) * 32 + g4 * 8) = o;
    }
  };
  gemm_stream<1>(44, setup, epi, smem);
}

#define XB_TMO      128
#define XB_XCNT(j)  (256  + 64 * (j))
#define XB_XSUB(j)  (1280 + 64 * (j))
#define XB_XGEN(j)  (2304 + 64 * (j))
#define XB_TOP      3328
#define XB_TOPGEN   3392
#define XCD_BAR_WORDS 3456
#define XB_SPIN_CAP (1u << 18)
#define LAS __attribute__((address_space(3)))

__device__ __forceinline__ unsigned xb_ld(unsigned* p)              { return __hip_atomic_load(p, __ATOMIC_RELAXED, __HIP_MEMORY_SCOPE_AGENT); }
__device__ __forceinline__ unsigned xb_add(unsigned* p, unsigned v) { return __hip_atomic_fetch_add(p, v, __ATOMIC_RELAXED, __HIP_MEMORY_SCOPE_AGENT); }
__device__ __forceinline__ unsigned xb_xcc_id() { return (unsigned)__builtin_amdgcn_s_getreg((3 << 11) | 20) & 0xFu; }
#define XB_SPIN(cond, bar) do { unsigned _sp = 0; while (cond) { __builtin_amdgcn_s_sleep(1); \
    if ((++_sp & 255u) == 0u) { if (xb_ld(&(bar)[XB_TMO])) break; if (_sp > XB_SPIN_CAP) { atomicAdd(&(bar)[XB_TMO], 1u); break; } } } } while (0)

struct XcdBarrier {
    unsigned* bar; unsigned x;
    volatile LAS unsigned* st;
};

__device__ __forceinline__ XcdBarrier xcd_barrier_post(unsigned* bar, volatile LAS unsigned* st) {
    XcdBarrier b; b.bar = bar; b.x = xb_xcc_id(); b.st = st;
    if (threadIdx.x == 0) (void)xb_add(&bar[XB_XCNT(b.x)], 1u);
    return b;
}
__device__ __forceinline__ void xcd_barrier_complete(unsigned* bar, unsigned x, unsigned& nloc, unsigned& nx) {
    const unsigned G = gridDim.x * gridDim.y * gridDim.z;
    unsigned sum, cnt, mine, sp = 0u;
    for (;;) {
        sum = 0u; cnt = 0u; mine = 0u;
#pragma unroll
        for (unsigned j = 0; j < 16; ++j) { const unsigned c = xb_ld(&bar[XB_XCNT(j)]); sum += c; cnt += (c > 0u) ? 1u : 0u; mine = (j == x) ? c : mine; }
        if (sum == G) break;
        __builtin_amdgcn_s_sleep(1);
        if ((++sp & 255u) == 0u) { if (xb_ld(&bar[XB_TMO])) break; if (sp > XB_SPIN_CAP) { atomicAdd(&bar[XB_TMO], 1u); break; } }
    }
    nloc = mine > 0u ? mine : 1u; nx = cnt > 0u ? cnt : 1u;
}

__device__ __forceinline__ void xcd_barrier(const XcdBarrier& b) {
    asm volatile("s_waitcnt vmcnt(0)" ::: "memory");
    __syncthreads();
    if (threadIdx.x == 0) {
        unsigned* bar = b.bar;
        __builtin_amdgcn_s_waitcnt(0);
        unsigned nloc = b.st[0], nx = b.st[1];
        if (nloc == 0u) { xcd_barrier_complete(bar, b.x, nloc, nx); b.st[0] = nloc; b.st[1] = nx; }
        const unsigned old = xb_add(&bar[XB_XSUB(b.x)], 1u);
        const unsigned gen = old / nloc;
        if (old + 1u == (gen + 1u) * nloc) {
            __builtin_amdgcn_fence(__ATOMIC_RELEASE, "agent");
            asm volatile("s_waitcnt vmcnt(0)" ::: "memory");
            const unsigned og = xb_add(&bar[XB_TOP], 1u);
            const unsigned tg = og / nx;
            if (og + 1u == (tg + 1u) * nx) xb_add(&bar[XB_TOPGEN], 1u);
            else XB_SPIN(xb_ld(&bar[XB_TOPGEN]) == tg, bar);
            __builtin_amdgcn_fence(__ATOMIC_ACQUIRE, "agent");
            xb_add(&bar[XB_XGEN(b.x)], 1u);
            asm volatile("s_waitcnt vmcnt(0)" ::: "memory");
        } else {
            XB_SPIN(xb_ld(&bar[XB_XGEN(b.x)]) == gen, bar);
            __builtin_amdgcn_fence(__ATOMIC_ACQUIRE, "agent");
            asm volatile("s_waitcnt vmcnt(0)" ::: "memory");
        }
    }
    __syncthreads();
}


__global__ void __launch_bounds__(256, 2) mega(Params p) {
  __shared__ __attribute__((aligned(16))) char smem[SMEM_BYTES];
  __shared__ uint4 xb_words;
  if (threadIdx.x == 0) xb_words = make_uint4(0u, 0u, 0u, 0u);
  __syncthreads();
  XcdBarrier xb = xcd_barrier_post((unsigned*)(p.ws + OFF_BAR), (volatile LAS unsigned*)&xb_words);
  for (int ph = p.phase_begin; ph < p.phase_end; ++ph) {
    if (ph > p.phase_begin) {
      if (p.phase_end < 0) cg::this_grid().sync();
      xcd_barrier(xb);
    }
    if (ph == 0) { if (PH_MASK & 1) phase_prologue(p, smem); continue; }
    const int l = (ph - 1) / 9, k = (ph - 1) % 9;
    for (int rep = 0; rep <= ((REP_MASK >> k) & 1); ++rep)
    switch (k) {
      case 0: if (PH_MASK & (2<<0)) phase_gemm1(p, l, smem); break;
      case 1: if (PH_MASK & (2<<1)) phase_conv_compress(p, l, smem); break;
      case 2: if (PH_MASK & (2<<2)) phase_attention(p, l, smem); break;
      case 3: if (PH_MASK & (2<<3)) phase_merge(p, l, smem); break;
      case 4: if (PH_MASK & (2<<4)) phase_resgemm(p, (const u16*)(p.ws + OFF_MRG), 1024, (const u16*)(p.ws + OFF_WO) + (size_t)l * 1024 * 1024,
                            l == 0 ? p.x : nullptr, p.ln2_g, p.ln2_b, smem); break;
      case 5: if (PH_MASK & (2<<5)) phase_ln(p, p.ln1_g + l * 1024, p.ln1_b + l * 1024, false); break;
      case 6: if (PH_MASK & (2<<6)) phase_ffn1(p, l, smem); break;
      case 7: if (PH_MASK & (2<<7)) phase_resgemm(p, (const u16*)(p.ws + OFF_H), DFF, (const u16*)(p.ws + OFF_WF2) + (size_t)l * 1024 * DFF,
                            nullptr, p.ln1_g + l * 1024, p.ln1_b + l * 1024, smem); break;
      case 8: if (PH_MASK & (2<<8)) phase_ln(p, p.ln2_g + l * 1024, p.ln2_b + l * 1024, l == 1); break;
    }
  }
}

extern "C" void kernel_launch(void* const* d_in, const int* in_sizes, int n_in, void* d_out, int out_size, void* d_ws,
                              size_t ws_size, hipStream_t stream) {
  static int grid_blocks = 0;
  if (!grid_blocks) {
    int dev = 0, cus = 0, per_cu = 0;
    hipGetDevice(&dev);
    hipDeviceGetAttribute(&cus, hipDeviceAttributeMultiprocessorCount, dev);
    hipOccupancyMaxActiveBlocksPerMultiprocessor(&per_cu, mega, 256, 0);
    if (per_cu < 1) per_cu = 1;
    if (per_cu > 2) per_cu = 2;
    grid_blocks = (cus * per_cu) & ~7;
    if (grid_blocks < 8) grid_blocks = 8;
  }
  if (ws_size < OFF_END) fprintf(stderr, "workspace too small: %zu < %zu\n", ws_size, (size_t)OFF_END);
  Params p{};
  p.x = (const float*)d_in[0]; p.w_in = (const float*)d_in[1]; p.conv_w = (const float*)d_in[2];
  p.w_conv_out = (const float*)d_in[3]; p.cmp_pos = (const float*)d_in[4]; p.cmp_w1 = (const float*)d_in[5];
  p.cmp_b1 = (const float*)d_in[6]; p.cmp_w2 = (const float*)d_in[7]; p.w_o = (const float*)d_in[8];
  p.ln1_g = (const float*)d_in[9]; p.ln1_b = (const float*)d_in[10]; p.w_ffn_in = (const float*)d_in[11];
  p.w_ffn_out = (const float*)d_in[12]; p.ln2_g = (const float*)d_in[13]; p.ln2_b = (const float*)d_in[14];
  p.out = (float*)d_out; p.ws = (char*)d_ws;
  hipMemsetAsync((char*)d_ws + OFF_BAR, 0, 16384, stream);
#if ONE_LAUNCH
  p.phase_begin = 0; p.phase_end = 19;
  void* args[] = {&p};
  hipError_t e = hipLaunchCooperativeKernel((void*)mega, dim3(grid_blocks), dim3(256), args, 0, stream);
  if (e != hipSuccess) fprintf(stderr, "cooperative launch failed: %s (grid %d)\n", hipGetErrorString(e), grid_blocks);
#else
  for (int ph = 0; ph < 19; ++ph) {
    p.phase_begin = ph; p.phase_end = ph + 1;
    mega<<<grid_blocks, 256, 0, stream>>>(p);
  }
#endif
}
```

```cpp
#include <hip/hip_runtime.h>
#include <hip/hip_cooperative_groups.h>
#include <cstdio>
#include <cstdint>
namespace cg = cooperative_groups;

#ifndef PH_MASK
#define PH_MASK 0xFFFF
#endif
#ifndef REP_MASK
#define REP_MASK 0
#endif
#ifndef ONE_LAUNCH
#define ONE_LAUNCH 1
#endif

typedef __attribute__((ext_vector_type(8))) short bf16x8;
typedef __attribute__((ext_vector_type(4))) float f32x4;
typedef __attribute__((ext_vector_type(2))) __bf16 bf16v2;
typedef unsigned short u16;
typedef __attribute__((ext_vector_type(4))) unsigned u32x4;
typedef __attribute__((ext_vector_type(2))) unsigned u32x2;

constexpr int T_ = 32768, S_ = 8192, D_ = 1024, NIN = 6192, DFF = 2816;
constexpr int N1 = 4224;
constexpr float ALPHA = 1.4142135623730951f;
constexpr float LOG2E = 1.4426950408889634f;

constexpr size_t MiB = 1ull << 20;
constexpr size_t OFF_WIN = 0;
constexpr size_t OFF_WMG = OFF_WIN + 2ull * N1 * 1024 * 2;
constexpr size_t OFF_WCO = OFF_WMG + 2ull * 2048 * 1024 * 2;
constexpr size_t OFF_WO  = OFF_WCO + 2ull * 1024 * 512 * 2;
constexpr size_t OFF_WF1 = OFF_WO  + 2ull * 1024 * 1024 * 2;
constexpr size_t OFF_WF2 = OFF_WF1 + 2ull * 5632 * 1024 * 2;
constexpr size_t OFF_WC1 = OFF_WF2 + 2ull * 1024 * 2816 * 2;
constexpr size_t OFF_WC2 = OFF_WC1 + 4ull * 128 * 2048 * 2;
constexpr size_t OFF_PB  = OFF_WC2 + 4ull * 64 * 128 * 2;
constexpr size_t OFF_KCMP = OFF_PB + 4096;
constexpr size_t OFF_VCMP = OFF_KCMP + 16ull * 512 * 64 * 2;
constexpr size_t OFF_GATE = OFF_VCMP + 16ull * 512 * 64 * 2;
constexpr size_t OFF_XB   = OFF_GATE + (size_t)T_ * 48 * 4;
constexpr size_t OFF_BV   = OFF_XB + (size_t)T_ * 1024 * 2;
constexpr size_t OFF_BCX  = OFF_BV + (size_t)T_ * 512 * 2;
constexpr size_t OFF_Q    = OFF_BCX + (size_t)T_ * 1536 * 2;
constexpr size_t OFF_KCVC = OFF_Q + (size_t)T_ * 1024 * 2;
constexpr size_t OFF_KSW  = OFF_KCVC + (size_t)T_ * 512 * 2;
constexpr size_t OFF_VST  = OFF_KSW + (size_t)T_ * 512 * 2;
constexpr size_t OFF_VWT  = OFF_VST + 16ull * 64 * S_ * 2;
constexpr size_t OFF_STAT = OFF_VWT + 16ull * 64 * S_ * 2;
constexpr size_t OFF_BAR  = OFF_STAT + (size_t)T_ * 8;
constexpr size_t OFF_END  = OFF_BAR + 16384;
constexpr size_t OFF_ATT  = OFF_BCX;
constexpr size_t OFF_MRG  = OFF_Q;
constexpr size_t OFF_H    = OFF_BCX;
static_assert(OFF_BCX + (size_t)T_ * DFF * 2 <= OFF_END, "h alias");
static_assert(OFF_END <= 512 * MiB, "ws");

struct Params {
  const float *x, *w_in, *conv_w, *w_conv_out, *cmp_pos, *cmp_w1, *cmp_b1, *cmp_w2, *w_o,
      *ln1_g, *ln1_b, *w_ffn_in, *w_ffn_out, *ln2_g, *ln2_b;
  float* out;
  char* ws;
  int phase_begin, phase_end;
};

constexpr int SMEM_BYTES = 73728;
constexpr int NRM_WORD = 3700;

__device__ __forceinline__ int otid() { int t = threadIdx.x; asm volatile("" : "+v"(t)); return t; }
__device__ __forceinline__ char* optr(char* q) { size_t z = 0; asm volatile("" : "+s"(z)); return q + z; }
__device__ __forceinline__ unsigned pack2(float a, float b) {
  bf16v2 v; v[0] = (__bf16)a; v[1] = (__bf16)b;
  return *reinterpret_cast<unsigned*>(&v);
}
__device__ __forceinline__ u16 f2bf(float a) { __bf16 v = (__bf16)a; return *reinterpret_cast<u16*>(&v); }
__device__ __forceinline__ float bf2f(unsigned h) { return __uint_as_float(h << 16); }
__device__ __forceinline__ float bflo(unsigned u) { return __uint_as_float(u << 16); }
__device__ __forceinline__ float bfhi(unsigned u) { return __uint_as_float(u & 0xFFFF0000u); }
__device__ __forceinline__ float sigmoidf_(float x) { return __builtin_amdgcn_rcpf(1.f + __expf(-x)); }
__device__ __forceinline__ f32x4 mfma16(bf16x8 a, bf16x8 b, f32x4 c) {
  return __builtin_amdgcn_mfma_f32_16x16x32_bf16(a, b, c, 0, 0, 0);
}

struct GUnit {
  const u16* A; const u16* B;
  unsigned aoff[4], boff[4];
  int akstep, nkt, m0, n0, step;
};
struct GPre { u32x4 a0[4], b0[4], a1[4], b1[4]; };

__device__ __forceinline__ void gemm_issue(GPre& r, const GUnit& u) {
#pragma unroll
  for (int j = 0; j < 4; ++j) {
    r.a0[j] = *reinterpret_cast<const u32x4*>(u.A + u.aoff[j]);
    r.b0[j] = *reinterpret_cast<const u32x4*>(u.B + u.boff[j]);
  }
#pragma unroll
  for (int j = 0; j < 4; ++j) {
    r.a1[j] = *reinterpret_cast<const u32x4*>(u.A + u.aoff[j] + (size_t)u.akstep);
    r.b1[j] = *reinterpret_cast<const u32x4*>(u.B + u.boff[j] + 64);
  }
}

template <class Next>
__device__ __forceinline__ void gemm_run(GPre& r, const GUnit& u, f32x4 (&acc)[4][4], char* smem, Next next) {
  const int tid = otid(), lane = tid & 63, w = tid >> 6, l15 = lane & 15, g4 = lane >> 4;
  const int wr = w >> 1, wc = w & 1;
  const int st_off = (tid >> 3) * 128 + ((((tid & 7) ^ ((tid >> 3) & 7))) << 4);
  const int rb = tid >> 3;
  const int rbp = (((rb >> 2) & 1) << 4) | (((rb >> 4) & 1) << 3) | (((rb >> 3) & 1) << 2) | (rb & 3);
  const int stb_off = 16384 + rbp * 128 + ((((tid & 7) ^ (rbp & 7))) << 4);
  const u16* A = u.A; const u16* B = u.B;
  const int akstep = u.akstep, nkt = u.nkt;
#pragma unroll
  for (int i = 0; i < 4; ++i)
#pragma unroll
    for (int j = 0; j < 4; ++j) acc[i][j] = f32x4{0.f, 0.f, 0.f, 0.f};
  auto ld0 = [&](int kt) {
    const size_t ka = (size_t)kt * akstep, kb = (size_t)kt * 64;
#pragma unroll
    for (int j = 0; j < 4; ++j) {
      r.a0[j] = *reinterpret_cast<const u32x4*>(A + u.aoff[j] + ka);
      r.b0[j] = *reinterpret_cast<const u32x4*>(B + u.boff[j] + kb);
    }
  };
  auto ld1 = [&](int kt) {
    const size_t ka = (size_t)kt * akstep, kb = (size_t)kt * 64;
#pragma unroll
    for (int j = 0; j < 4; ++j) {
      r.a1[j] = *reinterpret_cast<const u32x4*>(A + u.aoff[j] + ka);
      r.b1[j] = *reinterpret_cast<const u32x4*>(B + u.boff[j] + kb);
    }
  };
  auto st0 = [&](char* dst) {
#pragma unroll
    for (int j = 0; j < 4; ++j) {
      *reinterpret_cast<u32x4*>(dst + st_off + j * 4096) = r.a0[j];
      *reinterpret_cast<u32x4*>(dst + stb_off + j * 4096) = r.b0[j];
    }
  };
  auto st1 = [&](char* dst) {
#pragma unroll
    for (int j = 0; j < 4; ++j) {
      *reinterpret_cast<u32x4*>(dst + st_off + j * 4096) = r.a1[j];
      *reinterpret_cast<u32x4*>(dst + stb_off + j * 4096) = r.b1[j];
    }
  };
  auto compute = [&](const char* As) {
    const char* Bs = As + 16384;
    bf16x8 af[2][4], bfr[2][4];
#pragma unroll
    for (int ks = 0; ks < 2; ++ks) {
      const int coff = (((ks * 4 + g4) ^ (l15 & 7)) << 4);
#pragma unroll
      for (int mt = 0; mt < 4; ++mt)
        af[ks][mt] = *reinterpret_cast<const bf16x8*>(As + (wr * 64 + mt * 16 + l15) * 128 + coff);
#pragma unroll
      for (int nt = 0; nt < 4; ++nt)
        bfr[ks][nt] = *reinterpret_cast<const bf16x8*>(Bs + (wc * 64 + nt * 16 + l15) * 128 + coff);
    }
#pragma unroll
    for (int ks = 0; ks < 2; ++ks)
#pragma unroll
      for (int mt = 0; mt < 4; ++mt)
#pragma unroll
        for (int nt = 0; nt < 4; ++nt) acc[mt][nt] = mfma16(bfr[ks][nt], af[ks][mt], acc[mt][nt]);
  };
#define SGB(mask, n) __builtin_amdgcn_sched_group_barrier(mask, n, 0)
#define SGB_LOADS() SGB(0x008, 1); SGB(0x020, 1); SGB(0x008, 1); SGB(0x100, 1);
#define SGB_WRITES() SGB(0x008, 1); SGB(0x200, 1); SGB(0x008, 1);
#define SCHED_TILE()                                                                              \
  SGB(0x100, 8);                                                                                  \
  SGB_LOADS() SGB_LOADS() SGB_LOADS() SGB_LOADS() SGB_LOADS() SGB_LOADS() SGB_LOADS() SGB_LOADS() \
  SGB_WRITES() SGB_WRITES() SGB_WRITES() SGB_WRITES() SGB_WRITES() SGB_WRITES() SGB_WRITES() SGB_WRITES()
  st0(smem);
  __syncthreads();
#pragma unroll 1
  for (int kt = 0; kt < nkt - 2; kt += 2) {
    __builtin_amdgcn_s_setprio(1);
    ld0(kt + 2);
    compute(smem);
    st1(smem + 32768);
    SCHED_TILE()
    __builtin_amdgcn_s_setprio(0);
    __syncthreads();
    __builtin_amdgcn_s_setprio(1);
    ld1(kt + 3);
    compute(smem + 32768);
    st0(smem);
    SCHED_TILE()
    __builtin_amdgcn_s_setprio(0);
    __syncthreads();
  }
  GUnit nu;
  next(nu);
  __builtin_amdgcn_s_setprio(1);
#pragma unroll
  for (int j = 0; j < 4; ++j) {
    r.a0[j] = *reinterpret_cast<const u32x4*>(nu.A + nu.aoff[j]);
    r.b0[j] = *reinterpret_cast<const u32x4*>(nu.B + nu.boff[j]);
  }
  compute(smem);
  st1(smem + 32768);
  SCHED_TILE()
  __builtin_amdgcn_s_setprio(0);
  __syncthreads();
  __builtin_amdgcn_s_setprio(1);
#pragma unroll
  for (int j = 0; j < 4; ++j) {
    r.a1[j] = *reinterpret_cast<const u32x4*>(nu.A + nu.aoff[j] + (size_t)nu.akstep);
    r.b1[j] = *reinterpret_cast<const u32x4*>(nu.B + nu.boff[j] + 64);
  }
  compute(smem + 32768);
  SGB(0x100, 8);
  SGB_LOADS() SGB_LOADS() SGB_LOADS() SGB_LOADS() SGB_LOADS() SGB_LOADS() SGB_LOADS() SGB_LOADS()
  __builtin_amdgcn_s_setprio(0);
  __syncthreads();
#undef SCHED_TILE
#undef SGB_WRITES
#undef SGB_LOADS
#undef SGB
}

__device__ __forceinline__ void std_offsets(unsigned (&off)[4], int r0, int ld) {
  const int tid = otid();
#pragma unroll
  for (int j = 0; j < 4; ++j) off[j] = (unsigned)(r0 + (tid >> 3) + 32 * j) * (unsigned)ld + (tid & 7) * 8;
}

template <int NSTEPS, class Setup, class Epi>
__device__ __forceinline__ void gemm_stream(int NT, Setup setup, Epi epi, char* smem) {
  const int xcd = blockIdx.x & 7, lb = blockIdx.x >> 3, nlb = gridDim.x >> 3, total = 32 * NT;
  int s = lb, step = 0;
  if (s >= total) return;
  GUnit cur;
  GPre pre;
  auto mk = [&](GUnit& u, int s_, int step_) {
    const int grp = s_ / (8 * NT), wv = s_ % (8 * NT);
    u.m0 = ((xcd * 4 + grp) * 8 + (wv & 7)) * 128;
    u.n0 = (wv >> 3) * 128;
    u.step = step_;
    setup(u);
  };
  mk(cur, s, 0);
  gemm_issue(pre, cur);
#pragma unroll 1
  while (true) {
    f32x4 acc[4][4];
    int ns = s, nstep = step + 1;
    if (nstep == NSTEPS) { nstep = 0; ns = s + nlb; }
    const bool has = ns < total;
    if (!has) { ns = s; nstep = step; }
    gemm_run(pre, cur, acc, smem, [&](GUnit& nu) { mk(nu, ns, nstep); });
    epi(cur, acc);
    if (!has) break;
    mk(cur, ns, nstep);
    s = ns; step = nstep;
  }
}

__device__ __forceinline__ void transpose_job(const float* __restrict__ src, int ld, int K, int N, int mode, u16* __restrict__ dst,
                              char* smem) {
  float* t = reinterpret_cast<float*>(smem);
  const int tid = otid(), tx = tid & 31, ty = tid >> 5;
  const int ntn = N / 32, ntk = K / 64;
  for (int tile = blockIdx.x; tile < ntn * ntk; tile += gridDim.x) {
    const int n0 = (tile % ntn) * 32, k0 = (tile / ntn) * 64;
    const int n = n0 + tx;
    int sc;
    if (mode == 0) sc = n;
    else if (mode == 1) sc = (n < 4144) ? n : -1;
    else if (mode == 2) sc = 4144 + n;
    else sc = ((n & 63) < 32) ? ((n >> 6) * 32 + (n & 63)) : (DFF + (n >> 6) * 32 + (n & 63) - 32);
#pragma unroll
    for (int i = 0; i < 8; ++i) {
      const int k = k0 + ty + 8 * i;
      t[(ty + 8 * i) * 33 + tx] = (sc >= 0) ? src[(size_t)k * ld + sc] : 0.f;
    }
    __syncthreads();
#pragma unroll
    for (int i = 0; i < 4; ++i) {
      const int nn = ty + 8 * i;
      const unsigned v = pack2(t[(2 * tx) * 33 + nn], t[(2 * tx + 1) * 33 + nn]);
      *reinterpret_cast<unsigned*>(dst + (size_t)(n0 + nn) * K + k0 + 2 * tx) = v;
    }
    __syncthreads();
  }
}

__device__ __forceinline__ void phase_prologue(const Params& p, char* smem) {
  char* ws = optr(p.ws);
  for (int l = 0; l < 2; ++l) {
    transpose_job(p.w_in + (size_t)l * D_ * NIN, NIN, 1024, N1, 1, (u16*)(ws + OFF_WIN) + (size_t)l * N1 * 1024, smem);
    transpose_job(p.w_in + (size_t)l * D_ * NIN, NIN, 1024, 2048, 2, (u16*)(ws + OFF_WMG) + (size_t)l * 2048 * 1024, smem);
    transpose_job(p.w_conv_out + (size_t)l * 512 * 1024, 1024, 512, 1024, 0, (u16*)(ws + OFF_WCO) + (size_t)l * 1024 * 512, smem);
    transpose_job(p.w_o + (size_t)l * 1024 * 1024, 1024, 1024, 1024, 0, (u16*)(ws + OFF_WO) + (size_t)l * 1024 * 1024, smem);
    transpose_job(p.w_ffn_in + (size_t)l * 1024 * 5632, 5632, 1024, 5632, 3, (u16*)(ws + OFF_WF1) + (size_t)l * 5632 * 1024, smem);
    transpose_job(p.w_ffn_out + (size_t)l * DFF * 1024, 1024, DFF, 1024, 0, (u16*)(ws + OFF_WF2) + (size_t)l * 1024 * DFF, smem);
    for (int kv = 0; kv < 2; ++kv) {
      transpose_job(p.cmp_w1 + (size_t)(l * 2 + kv) * 2048 * 128, 128, 2048, 128, 0, (u16*)(ws + OFF_WC1) + (size_t)(l * 2 + kv) * 128 * 2048, smem);
      transpose_job(p.cmp_w2 + (size_t)(l * 2 + kv) * 128 * 64, 64, 128, 64, 0, (u16*)(ws + OFF_WC2) + (size_t)(l * 2 + kv) * 64 * 128, smem);
    }
  }
  const int gtid = blockIdx.x * 256 + otid(), gsz = gridDim.x * 256;
  {
    u16* xb = (u16*)(ws + OFF_XB);
    for (size_t i = gtid; i < (size_t)T_ * D_ / 8; i += gsz) {
      const float4 a = reinterpret_cast<const float4*>(p.x)[2 * i], b = reinterpret_cast<const float4*>(p.x)[2 * i + 1];
      uint4 o; o.x = pack2(a.x, a.y); o.y = pack2(a.z, a.w); o.z = pack2(b.x, b.y); o.w = pack2(b.z, b.w);
      reinterpret_cast<uint4*>(xb)[i] = o;
    }
  }
  {
    const int gw = gtid >> 6, lane = otid() & 63;
    if (gw < 512) {
      const int lk = gw >> 7, n = gw & 127;
      const float* pos = p.cmp_pos + (size_t)lk * 2048;
      const float* w1 = p.cmp_w1 + (size_t)lk * 2048 * 128;
      float s = 0.f;
      for (int k = lane; k < 2048; k += 64) s += pos[k] * w1[(size_t)k * 128 + n];
      for (int o = 32; o > 0; o >>= 1) s += __shfl_xor(s, o);
      if (lane == 0) reinterpret_cast<float*>(ws + OFF_PB)[gw] = s + p.cmp_b1[lk * 128 + n];
    }
  }
  if (gtid < 16 * 64) {
    const int bg = gtid >> 6, d = gtid & 63;
    ((u16*)(ws + OFF_KCMP))[((size_t)bg * 512 + 511) * 64 + d] = 0;
    ((u16*)(ws + OFF_VCMP))[((size_t)bg * 64 + d) * 512 + 511] = 0;
  }
}

__device__ __forceinline__ void phase_gemm1(const Params& p, int l, char* smem) {
  char* ws = optr(p.ws);
  const u16* A = (const u16*)(ws + OFF_XB);
  const u16* B = (const u16*)(ws + OFF_WIN) + (size_t)l * N1 * 1024;
  const int tid = otid(), lane = tid & 63, w = tid >> 6, l15 = lane & 15, g4 = lane >> 4, wr = w >> 1, wc = w & 1;
  auto setup = [&](GUnit& u) {
    u.A = A; u.B = B; u.akstep = 64; u.nkt = 16;
    std_offsets(u.aoff, u.m0, 1024); std_offsets(u.boff, u.n0, 1024);
  };
  auto epi = [&](const GUnit& u, f32x4 (&acc)[4][4]) {
    const int m0 = u.m0, n0 = u.n0, nt_ = u.n0 >> 7;
    const int ntype = (nt_ >= 12 && nt_ < 20) ? 0 : (nt_ == 24 || nt_ == 25) ? 1 : (nt_ == 28 || nt_ == 29) ? 2 : -1;
    float wmax = 0.f;
#pragma unroll
    for (int mt = 0; mt < 4; ++mt) {
      const int m = m0 + wr * 64 + mt * 16 + l15;
      float rowsq = 0.f;
#pragma unroll
      for (int np = 0; np < 2; ++np) {
        const int n = n0 + wc * 64 + np * 32 + g4 * 8;
        const f32x4 v0 = acc[mt][2 * np], v1 = acc[mt][2 * np + 1];
        rowsq += v0[0] * v0[0] + v0[1] * v0[1] + v0[2] * v0[2] + v0[3] * v0[3] + v1[0] * v1[0] + v1[1] * v1[1] + v1[2] * v1[2] + v1[3] * v1[3];
        if (nt_ < 12) {
          u32x4 o; o[0] = pack2(v0[0], v0[1]); o[1] = pack2(v0[2], v0[3]); o[2] = pack2(v1[0], v1[1]); o[3] = pack2(v1[2], v1[3]);
          *reinterpret_cast<u32x4*>((u16*)(ws + OFF_BCX) + (size_t)m * 1536 + n) = o;
        } else if (nt_ < 20) {
          const float sc = 0.125f * LOG2E;
          u32x4 o; o[0] = pack2(v0[0] * sc, v0[1] * sc); o[1] = pack2(v0[2] * sc, v0[3] * sc);
          o[2] = pack2(v1[0] * sc, v1[1] * sc); o[3] = pack2(v1[2] * sc, v1[3] * sc);
          *reinterpret_cast<u32x4*>((u16*)(ws + OFF_Q) + (size_t)m * 1024 + (n - 1536)) = o;
        } else if (nt_ < 24) {
          u32x4 o; o[0] = pack2(v0[0], v0[1]); o[1] = pack2(v0[2], v0[3]); o[2] = pack2(v1[0], v1[1]); o[3] = pack2(v1[2], v1[3]);
          *reinterpret_cast<u32x4*>((u16*)(ws + OFF_KCVC) + (size_t)m * 512 + (n - 2560)) = o;
        } else if (nt_ < 26 || nt_ == 28 || nt_ == 29) {
          const int c = (nt_ < 26) ? (n - 3072) : (256 + n - 3584);
          u32x4 o; o[0] = pack2(v0[0], v0[1]); o[1] = pack2(v0[2], v0[3]); o[2] = pack2(v1[0], v1[1]); o[3] = pack2(v1[2], v1[3]);
          *reinterpret_cast<u32x4*>((u16*)(ws + OFF_KSW) + (size_t)m * 512 + c) = o;
        } else if (nt_ < 32) {
          const int c = (nt_ < 28) ? (n - 3328) : (n - 3840);
          u16* vt = (u16*)(ws + ((nt_ < 28) ? OFF_VST : OFF_VWT));
          const int b = m >> 13, sp = m & (S_ - 1), g = c >> 6, d = c & 63;
#pragma unroll
          for (int j = 0; j < 4; ++j) {
            vt[((size_t)((b * 4 + g) * 64 + d + j)) * S_ + sp] = f2bf(v0[j]);
            vt[((size_t)((b * 4 + g) * 64 + d + 4 + j)) * S_ + sp] = f2bf(v1[j]);
          }
        } else {
          const int c = n - 4096;
          if (c < 48) {
            float4 o; o.x = sigmoidf_(v0[0]); o.y = sigmoidf_(v0[1]); o.z = sigmoidf_(v0[2]); o.w = sigmoidf_(v0[3]);
            float4 o1; o1.x = sigmoidf_(v1[0]); o1.y = sigmoidf_(v1[1]); o1.z = sigmoidf_(v1[2]); o1.w = sigmoidf_(v1[3]);
            float* gp = (float*)(ws + OFF_GATE) + (size_t)m * 48 + c;
            *reinterpret_cast<float4*>(gp) = o;
            *reinterpret_cast<float4*>(gp + 4) = o1;
          }
        }
      }
      if (ntype >= 0) {
        rowsq += __shfl_xor(rowsq, 16);
        rowsq += __shfl_xor(rowsq, 32);
        wmax = fmaxf(wmax, rowsq);
      }
    }
    if (ntype >= 0) {
#pragma unroll
      for (int o = 1; o < 16; o <<= 1) wmax = fmaxf(wmax, __shfl_xor(wmax, o));
      if (ntype == 0) wmax *= (0.125f * LOG2E) * (0.125f * LOG2E);
      if (lane == 0) atomicMax((unsigned*)(ws + OFF_BAR) + NRM_WORD + l * 4 + ntype, __float_as_uint(wmax));
    }
  };
  gemm_stream<1>(33, setup, epi, smem);
}

__device__ __forceinline__ float gelu_tanh(float x) {
  const float u = 0.7978845608028654f * (x + 0.044715f * x * x * x);
  const float e = __expf(2.f * u);
  const float th = 1.f - 2.f / (e + 1.f);
  return 0.5f * x * (1.f + th);
}

__device__ __forceinline__ void compress_tile(const Params& p, int l, int kv, int mtile, char* smem) {
  char* ws = optr(p.ws);
  const int tid = otid(), lane = tid & 63, w = tid >> 6, l15 = lane & 15, g4 = lane >> 4, wr = w >> 1, wc = w & 1;
  const u16* A = (const u16*)(ws + OFF_KCVC);
  const u16* B = (const u16*)(ws + OFF_WC1) + (size_t)(l * 2 + kv) * 128 * 2048;
  unsigned aoff[4], boff[4];
#pragma unroll
  for (int j = 0; j < 4; ++j) {
    int r = mtile * 128 + (tid >> 3) + 32 * j;
    r = r < 8176 ? r : 8175;
    const int bg = r / 511, i = r - bg * 511;
    const int b = bg >> 2, g = bg & 3;
    aoff[j] = (unsigned)(b * S_ + 16 * i) * 512u + kv * 256 + g * 64 + (tid & 7) * 8;
  }
  std_offsets(boff, 0, 2048);
  f32x4 acc[4][4];
  {
    GUnit u; GPre pre;
    u.A = A; u.B = B; u.akstep = 512; u.nkt = 32; u.m0 = 0; u.n0 = 0; u.step = 0;
#pragma unroll
    for (int j = 0; j < 4; ++j) { u.aoff[j] = aoff[j]; u.boff[j] = boff[j]; }
    gemm_issue(pre, u);
    gemm_run(pre, u, acc, smem, [&](GUnit& nu) { nu = u; });
  }
  const float* pb = reinterpret_cast<const float*>(ws + OFF_PB) + (l * 2 + kv) * 128;
#pragma unroll
  for (int mt = 0; mt < 4; ++mt) {
    const int m = wr * 64 + mt * 16 + l15;
#pragma unroll
    for (int np = 0; np < 2; ++np) {
      const int n = wc * 64 + np * 32 + g4 * 8;
      const float4 b0 = *reinterpret_cast<const float4*>(pb + n);
      const float4 b1 = *reinterpret_cast<const float4*>(pb + n + 4);
      const f32x4 v0 = acc[mt][2 * np], v1 = acc[mt][2 * np + 1];
      u32x4 o;
      o[0] = pack2(gelu_tanh(v0[0] + b0.x), gelu_tanh(v0[1] + b0.y));
      o[1] = pack2(gelu_tanh(v0[2] + b0.z), gelu_tanh(v0[3] + b0.w));
      o[2] = pack2(gelu_tanh(v1[0] + b1.x), gelu_tanh(v1[1] + b1.y));
      o[3] = pack2(gelu_tanh(v1[2] + b1.z), gelu_tanh(v1[3] + b1.w));
      const int ch = n >> 3;
      *reinterpret_cast<u32x4*>(smem + m * 256 + (((ch ^ (m & 7))) << 4)) = o;
    }
  }
  __syncthreads();
  const u16* W2 = (const u16*)(ws + OFF_WC2) + (size_t)(l * 2 + kv) * 64 * 128;
  f32x4 a2[2][4];
#pragma unroll
  for (int i = 0; i < 2; ++i)
#pragma unroll
    for (int j = 0; j < 4; ++j) a2[i][j] = f32x4{0.f, 0.f, 0.f, 0.f};
#pragma unroll
  for (int ks = 0; ks < 4; ++ks) {
    bf16x8 af[2], bfr[4];
#pragma unroll
    for (int i = 0; i < 2; ++i) {
      const int m = w * 32 + i * 16 + l15;
      af[i] = *reinterpret_cast<const bf16x8*>(smem + m * 256 + ((((ks * 4 + g4) ^ (m & 7))) << 4));
    }
#pragma unroll
    for (int nt = 0; nt < 4; ++nt)
      bfr[nt] = *reinterpret_cast<const bf16x8*>(W2 + (nt * 16 + l15) * 128 + ks * 32 + g4 * 8);
#pragma unroll
    for (int i = 0; i < 2; ++i)
#pragma unroll
      for (int nt = 0; nt < 4; ++nt) a2[i][nt] = mfma16(bfr[nt], af[i], a2[i][nt]);
  }
  if (kv == 0) {
    float wmax = 0.f;
#pragma unroll
    for (int i = 0; i < 2; ++i) {
      const int r = mtile * 128 + w * 32 + i * 16 + l15;
      float rowsq = 0.f;
#pragma unroll
      for (int nt = 0; nt < 4; ++nt)
#pragma unroll
        for (int j = 0; j < 4; ++j) rowsq += a2[i][nt][j] * a2[i][nt][j];
      rowsq += __shfl_xor(rowsq, 16);
      rowsq += __shfl_xor(rowsq, 32);
      wmax = fmaxf(wmax, r < 8176 ? rowsq : 0.f);
    }
#pragma unroll
    for (int o = 1; o < 16; o <<= 1) wmax = fmaxf(wmax, __shfl_xor(wmax, o));
    if (lane == 0) atomicMax((unsigned*)(ws + OFF_BAR) + NRM_WORD + l * 4 + 3, __float_as_uint(wmax));
  }
#pragma unroll
  for (int i = 0; i < 2; ++i) {
    const int r = mtile * 128 + w * 32 + i * 16 + l15;
    if (r < 8176) {
      const int bg = r / 511, c = r - bg * 511;
#pragma unroll
      for (int nt = 0; nt < 4; ++nt) {
        const int d = nt * 16 + g4 * 4;
        if (kv == 0) {
          uint2 o; o.x = pack2(a2[i][nt][0], a2[i][nt][1]); o.y = pack2(a2[i][nt][2], a2[i][nt][3]);
          *reinterpret_cast<uint2*>((u16*)(ws + OFF_KCMP) + ((size_t)bg * 512 + c) * 64 + d) = o;
        } else {
#pragma unroll
          for (int j = 0; j < 4; ++j)
            ((u16*)(ws + OFF_VCMP))[((size_t)bg * 64 + d + j) * 512 + c] = f2bf(a2[i][nt][j]);
        }
      }
    }
  }
  __syncthreads();
}

__device__ __forceinline__ void phase_conv_compress(const Params& p, int l, char* smem) {
  char* ws = optr(p.ws);
  for (int t = blockIdx.x; t < 128; t += gridDim.x) compress_tile(p, l, t >> 6, t & 63, smem);
  const u16* bcx = (const u16*)(ws + OFF_BCX);
  u16* bv = (u16*)(ws + OFF_BV);
  const float* cw = p.conv_w + (size_t)l * 3 * 512;
  const int cb0 = (gridDim.x >= 256) ? 128 : 0;
  if ((int)blockIdx.x < cb0) return;
  for (size_t idx = (size_t)(blockIdx.x - cb0) * 256 + otid(); idx < (size_t)T_ * 64; idx += (size_t)(gridDim.x - cb0) * 256) {
    const int t = (int)(idx >> 6), c0 = (int)(idx & 63) * 8;
    const int s = t & (S_ - 1);
    float v[8];
#pragma unroll
    for (int i = 0; i < 8; ++i) v[i] = 0.f;
#pragma unroll
    for (int k = 0; k < 3; ++k) {
      const int dt = 2 - k;
      if (s - dt >= 0) {
        const uint4 cc = *reinterpret_cast<const uint4*>(bcx + (size_t)(t - dt) * 1536 + 512 + c0);
        const uint4 xx = *reinterpret_cast<const uint4*>(bcx + (size_t)(t - dt) * 1536 + 1024 + c0);
        const float4 w0 = *reinterpret_cast<const float4*>(cw + k * 512 + c0);
        const float4 w1 = *reinterpret_cast<const float4*>(cw + k * 512 + c0 + 4);
        v[0] += w0.x * bflo(cc.x) * bflo(xx.x); v[1] += w0.y * bfhi(cc.x) * bfhi(xx.x);
        v[2] += w0.z * bflo(cc.y) * bflo(xx.y); v[3] += w0.w * bfhi(cc.y) * bfhi(xx.y);
        v[4] += w1.x * bflo(cc.z) * bflo(xx.z); v[5] += w1.y * bfhi(cc.z) * bfhi(xx.z);
        v[6] += w1.z * bflo(cc.w) * bflo(xx.w); v[7] += w1.w * bfhi(cc.w) * bfhi(xx.w);
      }
    }
    const uint4 bb = *reinterpret_cast<const uint4*>(bcx + (size_t)t * 1536 + c0);
    uint4 o;
    o.x = pack2(v[0] * bflo(bb.x), v[1] * bfhi(bb.x));
    o.y = pack2(v[2] * bflo(bb.y), v[3] * bfhi(bb.y));
    o.z = pack2(v[4] * bflo(bb.z), v[5] * bfhi(bb.z));
    o.w = pack2(v[6] * bflo(bb.w), v[7] * bfhi(bb.w));
    *reinterpret_cast<uint4*>(bv + (size_t)t * 512 + c0) = o;
  }
}

constexpr int LDS_IMP = 32768;
constexpr int LDS_UNI = 32768 + 33024;
constexpr int LDS_CNT = LDS_UNI + 16;
constexpr int LDS_LIST = LDS_UNI + 32;

struct TileRegs { u32x4 k0, k1, v0, v1; };

__device__ __forceinline__ void attn_prefetch(TileRegs& r, const u16* Kb, size_t ldk, const u16* Vb, size_t ldv) {
  const int tid = otid();
  const int row = (tid >> 3), c = (tid & 7) * 8;
  r.k0 = *reinterpret_cast<const u32x4*>(Kb + row * ldk + c);
  r.k1 = *reinterpret_cast<const u32x4*>(Kb + (row + 32) * ldk + c);
  r.v0 = *reinterpret_cast<const u32x4*>(Vb + row * ldv + c);
  r.v1 = *reinterpret_cast<const u32x4*>(Vb + (row + 32) * ldv + c);
}
__device__ __forceinline__ void attn_stage(const TileRegs& r, char* buf) {
  const int tid = otid();
  const int off = (tid >> 3) * 128 + ((((tid & 7) ^ ((tid >> 3) & 7))) << 4);
  *reinterpret_cast<u32x4*>(buf + off) = r.k0;
  *reinterpret_cast<u32x4*>(buf + off + 4096) = r.k1;
  *reinterpret_cast<u32x4*>(buf + 8192 + off) = r.v0;
  *reinterpret_cast<u32x4*>(buf + 8192 + off + 4096) = r.v1;
}

template <int MODE, bool MASKED, bool SELECT>
__device__ __forceinline__ void attn_tile(const char* buf, const bf16x8 (&qf)[2][2], f32x4 (&O)[2][4], float (&lsum)[2],
                                          const float (&invl)[2], const float (&slope)[2], float x0, float stride,
                                          float wlimit, bool selected, float* impq, bool impacc,
                                          float& p3carry) {
  const int lane = otid() & 63, l15 = lane & 15, g4 = lane >> 4;
  f32x4 psum[4];
#pragma unroll
  for (int i = 0; i < 4; ++i) psum[i] = f32x4{0.f, 0.f, 0.f, 0.f};
  const char* Kl = buf;
  const char* Vl = buf + 8192;
  float e[4];
#pragma unroll
  for (int j = 0; j < 4; ++j) e[j] = stride * (float)(g4 * 4 + j);
  bf16x8 pf[2][2];
  {
    bf16x8 kf[4][2];
#pragma unroll
    for (int sub = 0; sub < 4; ++sub)
#pragma unroll
      for (int ks = 0; ks < 2; ++ks)
        kf[sub][ks] = *reinterpret_cast<const bf16x8*>(Kl + (sub * 16 + l15) * 128 + ((((ks * 4 + g4) ^ (l15 & 7))) << 4));
#pragma unroll
    for (int hh = 0; hh < 2; ++hh) {
      f32x4 s[4];
#pragma unroll
      for (int sub = 0; sub < 4; ++sub) {
        float xs = x0 + stride * 16.f * (float)sub;
        if (SELECT) xs = selected ? xs : -1e32f;
        f32x4 bias;
#pragma unroll
        for (int j = 0; j < 4; ++j) bias[j] = slope[hh] * (xs + e[j]);
        __builtin_amdgcn_s_setprio(1);
        s[sub] = mfma16(kf[sub][0], qf[hh][0], bias);
        s[sub] = mfma16(kf[sub][1], qf[hh][1], s[sub]);
        __builtin_amdgcn_s_setprio(0);
      }
      float ls = 0.f;
#pragma unroll
      for (int sub = 0; sub < 4; ++sub) {
        const float xs = x0 + stride * 16.f * (float)sub;
#pragma unroll
        for (int j = 0; j < 4; ++j) {
          float pv = __builtin_amdgcn_exp2f(s[sub][j]);
          if (MASKED) { const float dd = xs + e[j]; pv = (dd <= 0.f && dd > -wlimit) ? pv : 0.f; }
          if (MODE == 1) { pv *= invl[hh]; psum[sub][j] += pv; }
          else ls += pv;
          s[sub][j] = pv;
        }
      }
      if (MODE != 1) lsum[hh] += ls;
      if (MODE != 0) {
#pragma unroll
        for (int kk = 0; kk < 2; ++kk) {
          union { bf16x8 v; unsigned u[4]; } pk;
          pk.u[0] = pack2(s[2 * kk][0], s[2 * kk][1]);
          pk.u[1] = pack2(s[2 * kk][2], s[2 * kk][3]);
          pk.u[2] = pack2(s[2 * kk + 1][0], s[2 * kk + 1][1]);
          pk.u[3] = pack2(s[2 * kk + 1][2], s[2 * kk + 1][3]);
          pf[hh][kk] = pk.v;
        }
      }
    }
  }
  if (MODE != 0) {
#pragma unroll
    for (int dt = 0; dt < 4; ++dt) {
      const int d = dt * 16 + l15;
      bf16x8 vf[2];
#pragma unroll
      for (int kk = 0; kk < 2; ++kk) {
        union { bf16x8 v; uint2 u[2]; } vv;
        const int c0 = kk * 4 + (g4 >> 1);
        vv.u[0] = *reinterpret_cast<const uint2*>(Vl + d * 128 + (((c0 ^ (d & 7))) << 4) + (g4 & 1) * 8);
        vv.u[1] = *reinterpret_cast<const uint2*>(Vl + d * 128 + ((((c0 + 2) ^ (d & 7))) << 4) + (g4 & 1) * 8);
        vf[kk] = vv.v;
      }
      __builtin_amdgcn_s_setprio(1);
#pragma unroll
      for (int hh = 0; hh < 2; ++hh) {
        O[hh][dt] = mfma16(vf[0], pf[hh][0], O[hh][dt]);
        O[hh][dt] = mfma16(vf[1], pf[hh][1], O[hh][dt]);
      }
      __builtin_amdgcn_s_setprio(0);
    }
  }
  if (MODE == 1) {
    float prev3 = p3carry;
#pragma unroll
    for (int sub = 0; sub < 4; ++sub) {
      const float give = (g4 == 3) ? prev3 : psum[sub][3];
      const float carry = __shfl(give, (lane + 48) & 63);
      float* dst = impq + sub * 4 + g4;
      const float base = impacc ? *dst : 0.f;
      *dst = base + (psum[sub][0] + psum[sub][1] + psum[sub][2] + psum[sub][3] + carry);
      prev3 = psum[sub][3];
    }
    p3carry = prev3;
  }
}

__device__ __forceinline__ float red4(float v) {
  v += __shfl_xor(v, 16);
  v += __shfl_xor(v, 32);
  return v;
}

__device__ __forceinline__ void attn_item(const Params& p, int l, int b, int g, int qt, char* smem) {
  char* ws = optr(p.ws);
  const int tid = otid(), lane = tid & 63, w = tid >> 6, l15 = lane & 15, g4 = lane >> 4;
  const int q0 = qt * 64, ql = w * 16 + l15, tq = q0 + ql;
  const int bg = b * 4 + g;
  const u16* qb = (const u16*)(ws + OFF_Q);
  const u16* ksw = (const u16*)(ws + OFF_KSW);
  const u16* kcmp = (const u16*)(ws + OFF_KCMP) + (size_t)bg * 512 * 64;
  const u16* vcmp = (const u16*)(ws + OFF_VCMP) + (size_t)bg * 64 * 512;
  const u16* vst = (const u16*)(ws + OFF_VST) + (size_t)bg * 64 * S_;
  const u16* vwt = (const u16*)(ws + OFF_VWT) + (size_t)bg * 64 * S_;
  const float* gate = (const float*)(ws + OFF_GATE) + (size_t)(b * S_ + tq) * 48 + g * 12;
  u16* ao = (u16*)(ws + OFF_ATT) + (size_t)(b * S_ + tq) * 1024 + g * 256;
  float* imp = reinterpret_cast<float*>(smem + LDS_IMP);
  unsigned* uni = reinterpret_cast<unsigned*>(smem + LDS_UNI);
  int* cntp = reinterpret_cast<int*>(smem + LDS_CNT);
  int* list = reinterpret_cast<int*>(smem + LDS_LIST);

  bf16x8 qf[2][2];
  float slope[2], lsum[2], invl[2];
  f32x4 O[2][4];
  if (tid < 4) uni[tid] = 0u;
  for (int i = tid; i < 64 * 129; i += 256) imp[i] = 0.f;

  const int nct = (4 * qt + 3 + 63) >> 6;
  const int kb0 = qt >= 8 ? qt - 8 : 0;
  float sm_c, sm_w, sm_s;
  {
    unsigned* nw = (unsigned*)(ws + OFF_BAR) + NRM_WORD + l * 4;
    const float qn = sqrtf(__uint_as_float(__hip_atomic_load(nw + 0, __ATOMIC_RELAXED, __HIP_MEMORY_SCOPE_AGENT)));
    const float ksn = sqrtf(__uint_as_float(__hip_atomic_load(nw + 1, __ATOMIC_RELAXED, __HIP_MEMORY_SCOPE_AGENT)));
    const float kwn = sqrtf(__uint_as_float(__hip_atomic_load(nw + 2, __ATOMIC_RELAXED, __HIP_MEMORY_SCOPE_AGENT)));
    const float kcn = sqrtf(__uint_as_float(__hip_atomic_load(nw + 3, __ATOMIC_RELAXED, __HIP_MEMORY_SCOPE_AGENT)));
    sm_c = 152.f + 1.05f * qn * kcn; sm_w = 152.f + 1.05f * qn * kwn; sm_s = 152.f + 1.05f * qn * ksn;
  }
  int ct0 = 0, ncp = nct, kbs = kb0, nA = 2 * nct + (qt - kb0 + 1);
  auto set_cut = [&](float slope_min) {
    const float inv = 1.f / slope_min;
    const float xc = ((float)q0 - 1039.f - sm_c * inv) * (1.f / 1024.f);
    ct0 = xc > 0.f ? (int)ceilf(xc) : 0;
    ct0 = ct0 < nct - 1 ? ct0 : nct - 1;
    ncp = nct - ct0;
    const float xw = ((float)q0 - 63.f - sm_w * inv) * (1.f / 64.f);
    kbs = xw > 0.f ? (int)ceilf(xw) : 0;
    kbs = kbs > kb0 ? kbs : kb0;
    kbs = kbs < qt ? kbs : qt;
    nA = 2 * ncp + (qt - kbs + 1);
  };

  auto load_q = [&](int hp) {
#pragma unroll
    for (int hh = 0; hh < 2; ++hh) {
      const int h = hp * 2 + hh;
#pragma unroll
      for (int ks = 0; ks < 2; ++ks)
        qf[hh][ks] = *reinterpret_cast<const bf16x8*>(qb + (size_t)(b * S_ + tq) * 1024 + (g * 4 + h) * 64 + ks * 32 + g4 * 8);
      slope[hh] = exp2f(-0.5f * (float)(g * 4 + h + 1)) * LOG2E;
      lsum[hh] = 0.f; invl[hh] = 0.f;
#pragma unroll
      for (int dt = 0; dt < 4; ++dt) O[hh][dt] = f32x4{0.f, 0.f, 0.f, 0.f};
    }
  };
  auto srcA = [&](int e, const u16*& Kb, size_t& ldk, const u16*& Vb, size_t& ldv) {
    if (e < 2 * ncp) {
      const int ct = ct0 + (e < ncp ? e : e - ncp);
      Kb = kcmp + (size_t)ct * 64 * 64; ldk = 64; Vb = vcmp + ct * 64; ldv = 512;
    } else {
      const int pos0 = (kbs + e - 2 * ncp) * 64;
      Kb = ksw + (size_t)(b * S_ + pos0) * 512 + 256 + g * 64; ldk = 512; Vb = vwt + pos0; ldv = S_;
    }
  };
  auto fold = [&](int hp, int br) {
#pragma unroll
    for (int hh = 0; hh < 2; ++hh) {
      const int h = hp * 2 + hh;
      float sc = gate[h * 3 + br];
      if (br != 0) { const float l = red4(lsum[hh]); sc *= (l > 0.f) ? 1.f / l : 0.f; }
#pragma unroll
      for (int dt = 0; dt < 4; ++dt) {
        uint2* dst = reinterpret_cast<uint2*>(ao + h * 64 + dt * 16 + g4 * 4);
        uint2 old; old.x = 0u; old.y = 0u;
        if (br != 0) old = *dst;
        const float a0 = bflo(old.x) + sc * O[hh][dt][0], a1 = bfhi(old.x) + sc * O[hh][dt][1];
        const float a2 = bflo(old.y) + sc * O[hh][dt][2], a3 = bfhi(old.y) + sc * O[hh][dt][3];
        uint2 o; o.x = pack2(a0, a1); o.y = pack2(a2, a3);
        *dst = o;
        O[hh][dt] = f32x4{0.f, 0.f, 0.f, 0.f};
      }
      lsum[hh] = 0.f;
    }
  };

  TileRegs tr;
#pragma unroll 1
  for (int hp = 0; hp < 2; ++hp) {
    load_q(hp);
    set_cut(slope[1]);
    float p3carry = 0.f;
    {
      const u16 *Kb, *Vb; size_t ldk, ldv;
      srcA(0, Kb, ldk, Vb, ldv);
      attn_prefetch(tr, Kb, ldk, Vb, ldv);
    }
#pragma unroll 1
    for (int e = 0; e < nA; ++e) {
      char* buf = smem + (e & 1) * 16384;
      attn_stage(tr, buf);
      __syncthreads();
      if (e + 1 < nA) {
        const u16 *Kb, *Vb; size_t ldk, ldv;
        srcA(e + 1, Kb, ldk, Vb, ldv);
        attn_prefetch(tr, Kb, ldk, Vb, ldv);
      }
      if (e < ncp) {
        attn_tile<0, true, false>(buf, qf, O, lsum, invl, slope, (float)((ct0 + e) * 1024 + 31 - tq), 16.f, 1e9f, true, imp, false, p3carry);
      } else if (e < 2 * ncp) {
        const int ct = ct0 + e - ncp;
        if (e == ncp) {
#pragma unroll
          for (int hh = 0; hh < 2; ++hh) { const float l = red4(lsum[hh]); invl[hh] = (l > 0.f) ? 1.f / l : 0.f; lsum[hh] = 0.f; }
          p3carry = 0.f;
        }
        attn_tile<1, true, false>(buf, qf, O, lsum, invl, slope, (float)(ct * 1024 + 31 - tq), 16.f, 1e9f, true,
                     imp + ql * 129 + ct * 16, true, p3carry);
      } else {
        if (e == 2 * ncp) fold(hp, 0);
        const int kb = kbs + e - 2 * ncp;
        const bool mk = (kb == qt) || (kb == qt - 8);
        if (mk) attn_tile<2, true, false>(buf, qf, O, lsum, invl, slope, (float)(kb * 64 - tq), 1.f, 512.f, true, imp, false, p3carry);
        else attn_tile<2, false, false>(buf, qf, O, lsum, invl, slope, (float)(kb * 64 - tq), 1.f, 512.f, true, imp, false, p3carry);
      }
    }
    fold(hp, 2);
    __syncthreads();
  }

  unsigned sel[4] = {0u, 0u, 0u, 0u};
  {
    unsigned key[32];
#pragma unroll
    for (int i = 0; i < 32; ++i) {
      const int j = g4 * 32 + i;
      const unsigned bits = __float_as_uint(imp[ql * 129 + j]);
      unsigned k = ((((bits >> 7) + 1u) << 7) & 0x7FFFFF80u) | (unsigned)(127 - j);
      if (j == 0 || j == qt || j == qt - 1) k = 0x80000000u | (unsigned)(127 - j);
      if (j > qt) k = 0u;
      key[i] = k;
    }
#pragma unroll 1
    for (int r = 0; r < 16; ++r) {
      unsigned m = 0u;
#pragma unroll
      for (int i = 0; i < 32; ++i) m = key[i] > m ? key[i] : m;
      unsigned o = __shfl_xor(m, 16); m = o > m ? o : m;
      o = __shfl_xor(m, 32); m = o > m ? o : m;
      if (m != 0u) {
        const int jw = 127 - (int)(m & 127u);
#pragma unroll
        for (int wi = 0; wi < 4; ++wi) sel[wi] |= ((jw >> 5) == wi) ? (1u << (jw & 31)) : 0u;
#pragma unroll
        for (int i = 0; i < 32; ++i) key[i] = (key[i] == m) ? 0u : key[i];
      }
    }
  }
  if (g4 == 0) {
#pragma unroll
    for (int wi = 0; wi < 4; ++wi) atomicOr(&uni[wi], sel[wi]);
  }
  __syncthreads();
  {
    const unsigned u0 = uni[0], u1 = uni[1], u2 = uni[2], u3 = uni[3];
    if (tid < 128) {
      const int j = tid, wi = j >> 5;
      const unsigned wv = wi == 0 ? u0 : wi == 1 ? u1 : wi == 2 ? u2 : u3;
      if ((wv >> (j & 31)) & 1u) {
        int pos = __popc(wv & ((1u << (j & 31)) - 1u));
        pos += (wi > 0 ? __popc(u0) : 0) + (wi > 1 ? __popc(u1) : 0) + (wi > 2 ? __popc(u2) : 0);
        list[pos] = j;
      }
    }
    if (tid == 0) *cntp = __popc(u0) + __popc(u1) + __popc(u2) + __popc(u3);
  }
  __syncthreads();
  const int nB = *cntp;

  float p3c2 = 0.f;
#pragma unroll 1
  for (int hp = 0; hp < 2; ++hp) {
    load_q(hp);
    int e0 = 0;
    {
      const float xs = ((float)q0 - 63.f - sm_s / slope[1]) * (1.f / 64.f);
      const int jmin = xs > 0.f ? (int)ceilf(xs) : 0;
      while (e0 < nB - 1 && list[e0] < jmin) ++e0;
    }
    {
      const int j0 = list[e0];
      attn_prefetch(tr, ksw + (size_t)(b * S_ + j0 * 64) * 512 + g * 64, 512, vst + j0 * 64, S_);
    }
#pragma unroll 1
    for (int e = e0; e < nB; ++e) {
      char* buf = smem + (e & 1) * 16384;
      const int j = list[e];
      attn_stage(tr, buf);
      __syncthreads();
      if (e + 1 < nB) {
        const int jn = list[e + 1];
        attn_prefetch(tr, ksw + (size_t)(b * S_ + jn * 64) * 512 + g * 64, 512, vst + jn * 64, S_);
      }
      const unsigned wsel = (j < 32) ? sel[0] : (j < 64) ? sel[1] : (j < 96) ? sel[2] : sel[3];
      const bool sl = (wsel >> (j & 31)) & 1u;
      if (j == qt) attn_tile<2, true, true>(buf, qf, O, lsum, invl, slope, (float)(j * 64 - tq), 1.f, 1e9f, sl, imp, false, p3c2);
      else attn_tile<2, false, true>(buf, qf, O, lsum, invl, slope, (float)(j * 64 - tq), 1.f, 1e9f, sl, imp, false, p3c2);
    }
    fold(hp, 1);
    __syncthreads();
  }
}

__device__ __forceinline__ void phase_attention(const Params& p, int l, char* smem) {
  unsigned* ctr = (unsigned*)(p.ws + OFF_BAR) + 3600 + 64 * l;
  int* slot = reinterpret_cast<int*>(smem + LDS_CNT + 8);
  const int tid = otid();
#pragma unroll 1
  for (;;) {
    if (tid == 0) *slot = (int)atomicAdd(ctr, 1u);
    __syncthreads();
    const int idx = *slot;
    __syncthreads();
    if (idx >= 2048) break;
    const int qt = 127 - (idx >> 4), g = 3 - ((idx >> 2) & 3), b = idx & 3;
    attn_item(p, l, b, g, qt, smem);
  }
}

__device__ __forceinline__ void phase_merge(const Params& p, int l, char* smem) {
  char* ws = optr(p.ws);
  const u16* xb = (const u16*)(ws + OFF_XB);
  const u16* bv = (const u16*)(ws + OFF_BV);
  const u16* att = (const u16*)(ws + OFF_ATT);
  const u16* wco = (const u16*)(ws + OFF_WCO) + (size_t)l * 1024 * 512;
  const u16* wmg = (const u16*)(ws + OFF_WMG) + (size_t)l * 2048 * 1024;
  u16* mrg = (u16*)(ws + OFF_MRG);
  const int tid = otid(), lane = tid & 63, w = tid >> 6, l15 = lane & 15, g4 = lane >> 4, wr = w >> 1, wc = w & 1;
  auto setup = [&](GUnit& u) {
    if (u.step == 0) {
      u.A = bv; u.B = wco; u.akstep = 64; u.nkt = 8;
      std_offsets(u.aoff, u.m0, 512); std_offsets(u.boff, u.n0, 512);
    } else {
      u.A = xb; u.B = wmg; u.akstep = 64; u.nkt = 16;
      std_offsets(u.aoff, u.m0, 1024); std_offsets(u.boff, (u.step - 1) * 1024 + u.n0, 1024);
    }
  };
  auto epi = [&](const GUnit& u, f32x4 (&acc)[4][4]) {
    const int m0 = u.m0, n0 = u.n0, step = u.step;
#pragma unroll
    for (int mt = 0; mt < 4; ++mt) {
      const int m = m0 + wr * 64 + mt * 16 + l15;
#pragma unroll
      for (int np = 0; np < 2; ++np) {
        const int n = n0 + wc * 64 + np * 32 + g4 * 8;
        u32x4* dst = reinterpret_cast<u32x4*>(mrg + (size_t)m * 1024 + n);
        float r[8];
#pragma unroll
        for (int j = 0; j < 4; ++j) { r[j] = acc[mt][2 * np][j]; r[4 + j] = acc[mt][2 * np + 1][j]; }
        if (step == 1) {
          const u32x4 o = *dst;
#pragma unroll
          for (int q = 0; q < 4; ++q) { r[2 * q] = sigmoidf_(r[2 * q]) * bflo(o[q]); r[2 * q + 1] = sigmoidf_(r[2 * q + 1]) * bfhi(o[q]); }
        } else if (step == 2) {
          const u32x4 o = *dst;
          const u32x4 a = *reinterpret_cast<const u32x4*>(att + (size_t)m * 1024 + n);
#pragma unroll
          for (int q = 0; q < 4; ++q) {
            r[2 * q] = bflo(o[q]) + sigmoidf_(r[2 * q]) * bflo(a[q]);
            r[2 * q + 1] = bfhi(o[q]) + sigmoidf_(r[2 * q + 1]) * bfhi(a[q]);
          }
        }
        u32x4 o2; o2[0] = pack2(r[0], r[1]); o2[1] = pack2(r[2], r[3]); o2[2] = pack2(r[4], r[5]); o2[3] = pack2(r[6], r[7]);
        *dst = o2;
      }
    }
  };
  gemm_stream<3>(8, setup, epi, smem);
}

__device__ __forceinline__ void phase_resgemm(const Params& p, const u16* A, int K, const u16* Bt, const float* resid,
                                              const float* pg, const float* pb, char* smem) {
  const float2* stat = (const float2*)(optr(p.ws) + OFF_STAT);
  float* out = p.out;
  const int tid = otid(), lane = tid & 63, w = tid >> 6, l15 = lane & 15, g4 = lane >> 4, wr = w >> 1, wc = w & 1;
  auto setup = [&](GUnit& u) {
    u.A = A; u.B = Bt; u.akstep = 64; u.nkt = K / 64;
    std_offsets(u.aoff, u.m0, K); std_offsets(u.boff, u.n0, K);
  };
  auto epi = [&](const GUnit& u, f32x4 (&acc)[4][4]) {
    const int m0 = u.m0, n0 = u.n0;
#pragma unroll
    for (int mt = 0; mt < 4; ++mt) {
      const int m = m0 + wr * 64 + mt * 16 + l15;
#pragma unroll
      for (int nt = 0; nt < 4; ++nt) {
        const int n = n0 + wc * 64 + (nt >> 1) * 32 + g4 * 8 + (nt & 1) * 4;
        float4 r;
        if (resid) {
          r = *reinterpret_cast<const float4*>(resid + (size_t)m * 1024 + n);
        } else {
          const float4 y = *reinterpret_cast<const float4*>(out + (size_t)m * 1024 + n);
          const float2 st = stat[m];
          const float4 gg = *reinterpret_cast<const float4*>(pg + n);
          const float4 bb = *reinterpret_cast<const float4*>(pb + n);
          r.x = (y.x - st.x) * st.y * gg.x + bb.x; r.y = (y.y - st.x) * st.y * gg.y + bb.y;
          r.z = (y.z - st.x) * st.y * gg.z + bb.z; r.w = (y.w - st.x) * st.y * gg.w + bb.w;
        }
        float4 o;
        o.x = ALPHA * r.x + acc[mt][nt][0]; o.y = ALPHA * r.y + acc[mt][nt][1];
        o.z = ALPHA * r.z + acc[mt][nt][2]; o.w = ALPHA * r.w + acc[mt][nt][3];
        *reinterpret_cast<float4*>(out + (size_t)m * 1024 + n) = o;
      }
    }
  };
  gemm_stream<1>(8, setup, epi, smem);
}

__device__ __forceinline__ void phase_ln(const Params& p, const float* gam, const float* bet, bool write_f32) {
  float* out = p.out;
  u16* xb = (u16*)(p.ws + OFF_XB);
  float2* stat = (float2*)(p.ws + OFF_STAT);
  const int lane = otid() & 63;
  const int gw = (blockIdx.x * 256 + otid()) >> 6, nw = gridDim.x * 4;
#pragma unroll 1
  for (int row0 = gw; row0 < T_; row0 += 2 * nw) {
    const int row1 = row0 + nw;
    const bool has1 = row1 < T_;
    const float* r0p = out + (size_t)row0 * 1024 + lane * 4;
    const float* r1p = out + (size_t)(has1 ? row1 : row0) * 1024 + lane * 4;
    f32x4 a0 = *reinterpret_cast<const f32x4*>(r0p), a1 = *reinterpret_cast<const f32x4*>(r0p + 256);
    f32x4 a2 = *reinterpret_cast<const f32x4*>(r0p + 512), a3 = *reinterpret_cast<const f32x4*>(r0p + 768);
    f32x4 b0 = *reinterpret_cast<const f32x4*>(r1p), b1 = *reinterpret_cast<const f32x4*>(r1p + 256);
    f32x4 b2 = *reinterpret_cast<const f32x4*>(r1p + 512), b3 = *reinterpret_cast<const f32x4*>(r1p + 768);
    f32x4 ta = a0 + a1 + a2 + a3, tb = b0 + b1 + b2 + b3;
    float sa = ta[0] + ta[1] + ta[2] + ta[3], sb = tb[0] + tb[1] + tb[2] + tb[3];
    for (int o = 32; o > 0; o >>= 1) { sa += __shfl_xor(sa, o); sb += __shfl_xor(sb, o); }
    const float mua = sa * (1.f / 1024.f), mub = sb * (1.f / 1024.f);
    a0 -= mua; a1 -= mua; a2 -= mua; a3 -= mua;
    b0 -= mub; b1 -= mub; b2 -= mub; b3 -= mub;
    ta = a0 * a0 + a1 * a1 + a2 * a2 + a3 * a3; tb = b0 * b0 + b1 * b1 + b2 * b2 + b3 * b3;
    float qa = ta[0] + ta[1] + ta[2] + ta[3], qb = tb[0] + tb[1] + tb[2] + tb[3];
    for (int o = 32; o > 0; o >>= 1) { qa += __shfl_xor(qa, o); qb += __shfl_xor(qb, o); }
    const float rsa = rsqrtf(qa * (1.f / 1024.f) + 1e-5f), rsb = rsqrtf(qb * (1.f / 1024.f) + 1e-5f);
    if (!write_f32 && lane == 0) {
      stat[row0] = make_float2(mua, rsa);
      if (has1) stat[row1] = make_float2(mub, rsb);
    }
#define LN_OUT(V, RS, ROW, C)                                                                       \
    {                                                                                               \
      const f32x4 gg = *reinterpret_cast<const f32x4*>(gam + (C) + lane * 4);                       \
      const f32x4 bb = *reinterpret_cast<const f32x4*>(bet + (C) + lane * 4);                       \
      const f32x4 o = V * RS * gg + bb;                                                             \
      if (write_f32) {     \
        *reinterpret_cast<f32x4*>(out + (size_t)(ROW) * 1024 + (C) + lane * 4) = o;                 \
      } else {                                                                                      \
        u32x2 ob; ob[0] = pack2(o[0], o[1]); ob[1] = pack2(o[2], o[3]);                             \
        *reinterpret_cast<u32x2*>(xb + (size_t)(ROW) * 1024 + (C) + lane * 4) = ob;                 \
      }                                                                                             \
    }
    LN_OUT(a0, rsa, row0, 0) LN_OUT(a1, rsa, row0, 256) LN_OUT(a2, rsa, row0, 512) LN_OUT(a3, rsa, row0, 768)
    if (has1) { LN_OUT(b0, rsb, row1, 0) LN_OUT(b1, rsb, row1, 256) LN_OUT(b2, rsb, row1, 512) LN_OUT(b3, rsb, row1, 768) }
#undef LN_OUT
  }
}

__device__ __forceinline__ void phase_ffn1(const Params& p, int l, char* smem) {
  char* ws = optr(p.ws);
  const u16* A = (const u16*)(ws + OFF_XB);
  const u16* B = (const u16*)(ws + OFF_WF1) + (size_t)l * 5632 * 1024;
  u16* hb = (u16*)(ws + OFF_H);
  const int tid = otid(), lane = tid & 63, w = tid >> 6, l15 = lane & 15, g4 = lane >> 4, wr = w >> 1, wc = w & 1;
  auto setup = [&](GUnit& u) {
    u.A = A; u.B = B; u.akstep = 64; u.nkt = 16;
    std_offsets(u.aoff, u.m0, 1024); std_offsets(u.boff, u.n0, 1024);
  };
  auto epi = [&](const GUnit& u, f32x4 (&acc)[4][4]) {
    const int m0 = u.m0, nt_ = u.n0 >> 7;
#pragma unroll
    for (int mt = 0; mt < 4; ++mt) {
      const int m = m0 + wr * 64 + mt * 16 + l15;
      float hv[8];
#pragma unroll
      for (int q = 0; q < 2; ++q)
#pragma unroll
        for (int j = 0; j < 4; ++j) {
          const float a = acc[mt][q][j], uu = acc[mt][q + 2][j];
          hv[q * 4 + j] = a * sigmoidf_(a) * uu;
        }
      u32x4 o; o[0] = pack2(hv[0], hv[1]); o[1] = pack2(hv[2], hv[3]); o[2] = pack2(hv[4], hv[5]); o[3] = pack2(hv[6], hv[7]);
      *reinterpret_cast<u32x4*>(hb + (size_t)m * DFF + (nt_ * 2 + wc) * 32 + g4 * 8) = o;
    }
  };
  gemm_stream<1>(44, setup, epi, smem);
}

#define XB_TMO      128
#define XB_XCNT(j)  (256  + 64 * (j))
#define XB_XSUB(j)  (1280 + 64 * (j))
#define XB_XGEN(j)  (2304 + 64 * (j))
#define XB_TOP      3328
#define XB_TOPGEN   3392
#define XCD_BAR_WORDS 3456
#define XB_SPIN_CAP (1u << 18)
#define LAS __attribute__((address_space(3)))

__device__ __forceinline__ unsigned xb_ld(unsigned* p)              { return __hip_atomic_load(p, __ATOMIC_RELAXED, __HIP_MEMORY_SCOPE_AGENT); }
__device__ __forceinline__ unsigned xb_add(unsigned* p, unsigned v) { return __hip_atomic_fetch_add(p, v, __ATOMIC_RELAXED, __HIP_MEMORY_SCOPE_AGENT); }
__device__ __forceinline__ unsigned xb_xcc_id() { return (unsigned)__builtin_amdgcn_s_getreg((3 << 11) | 20) & 0xFu; }
#define XB_SPIN(cond, bar) do { unsigned _sp = 0; while (cond) { __builtin_amdgcn_s_sleep(1); \
    if ((++_sp & 255u) == 0u) { if (xb_ld(&(bar)[XB_TMO])) break; if (_sp > XB_SPIN_CAP) { atomicAdd(&(bar)[XB_TMO], 1u); break; } } } } while (0)

struct XcdBarrier {
    unsigned* bar; unsigned x;
    volatile LAS unsigned* st;
};

__device__ __forceinline__ XcdBarrier xcd_barrier_post(unsigned* bar, volatile LAS unsigned* st) {
    XcdBarrier b; b.bar = bar; b.x = xb_xcc_id(); b.st = st;
    if (threadIdx.x == 0) (void)xb_add(&bar[XB_XCNT(b.x)], 1u);
    return b;
}
__device__ __forceinline__ void xcd_barrier_complete(unsigned* bar, unsigned x, unsigned& nloc, unsigned& nx) {
    const unsigned G = gridDim.x * gridDim.y * gridDim.z;
    unsigned sum, cnt, mine, sp = 0u;
    for (;;) {
        sum = 0u; cnt = 0u; mine = 0u;
#pragma unroll
        for (unsigned j = 0; j < 16; ++j) { const unsigned c = xb_ld(&bar[XB_XCNT(j)]); sum += c; cnt += (c > 0u) ? 1u : 0u; mine = (j == x) ? c : mine; }
        if (sum == G) break;
        __builtin_amdgcn_s_sleep(1);
        if ((++sp & 255u) == 0u) { if (xb_ld(&bar[XB_TMO])) break; if (sp > XB_SPIN_CAP) { atomicAdd(&bar[XB_TMO], 1u); break; } }
    }
    nloc = mine > 0u ? mine : 1u; nx = cnt > 0u ? cnt : 1u;
}

__device__ __forceinline__ void xcd_barrier(const XcdBarrier& b) {
    asm volatile("s_waitcnt vmcnt(0)" ::: "memory");
    __syncthreads();
    if (threadIdx.x == 0) {
        unsigned* bar = b.bar;
        __builtin_amdgcn_s_waitcnt(0);
        unsigned nloc = b.st[0], nx = b.st[1];
        if (nloc == 0u) { xcd_barrier_complete(bar, b.x, nloc, nx); b.st[0] = nloc; b.st[1] = nx; }
        const unsigned old = xb_add(&bar[XB_XSUB(b.x)], 1u);
        const unsigned gen = old / nloc;
        if (old + 1u == (gen + 1u) * nloc) {
            __builtin_amdgcn_fence(__ATOMIC_RELEASE, "agent");
            asm volatile("s_waitcnt vmcnt(0)" ::: "memory");
            const unsigned og = xb_add(&bar[XB_TOP], 1u);
            const unsigned tg = og / nx;
            if (og + 1u == (tg + 1u) * nx) xb_add(&bar[XB_TOPGEN], 1u);
            else XB_SPIN(xb_ld(&bar[XB_TOPGEN]) == tg, bar);
            __builtin_amdgcn_fence(__ATOMIC_ACQUIRE, "agent");
            xb_add(&bar[XB_XGEN(b.x)], 1u);
            asm volatile("s_waitcnt vmcnt(0)" ::: "memory");
        } else {
            XB_SPIN(xb_ld(&bar[XB_XGEN(b.x)]) == gen, bar);
            __builtin_amdgcn_fence(__ATOMIC_ACQUIRE, "agent");
            asm volatile("s_waitcnt vmcnt(0)" ::: "memory");
        }
    }
    __syncthreads();
}


__global__ void __launch_bounds__(256, 2) mega(Params p) {
  __shared__ __attribute__((aligned(16))) char smem[SMEM_BYTES];
  __shared__ uint4 xb_words;
  if (threadIdx.x == 0) xb_words = make_uint4(0u, 0u, 0u, 0u);
  __syncthreads();
  XcdBarrier xb = xcd_barrier_post((unsigned*)(p.ws + OFF_BAR), (volatile LAS unsigned*)&xb_words);
  for (int ph = p.phase_begin; ph < p.phase_end; ++ph) {
    if (ph > p.phase_begin) {
      if (p.phase_end < 0) cg::this_grid().sync();
      xcd_barrier(xb);
    }
    if (ph == 0) { if (PH_MASK & 1) phase_prologue(p, smem); continue; }
    const int l = (ph - 1) / 9, k = (ph - 1) % 9;
    for (int rep = 0; rep <= ((REP_MASK >> k) & 1); ++rep)
    switch (k) {
      case 0: if (PH_MASK & (2<<0)) phase_gemm1(p, l, smem); break;
      case 1: if (PH_MASK & (2<<1)) phase_conv_compress(p, l, smem); break;
      case 2: if (PH_MASK & (2<<2)) phase_attention(p, l, smem); break;
      case 3: if (PH_MASK & (2<<3)) phase_merge(p, l, smem); break;
      case 4: if (PH_MASK & (2<<4)) phase_resgemm(p, (const u16*)(p.ws + OFF_MRG), 1024, (const u16*)(p.ws + OFF_WO) + (size_t)l * 1024 * 1024,
                            l == 0 ? p.x : nullptr, p.ln2_g, p.ln2_b, smem); break;
      case 5: if (PH_MASK & (2<<5)) phase_ln(p, p.ln1_g + l * 1024, p.ln1_b + l * 1024, false); break;
      case 6: if (PH_MASK & (2<<6)) phase_ffn1(p, l, smem); break;
      case 7: if (PH_MASK & (2<<7)) phase_resgemm(p, (const u16*)(p.ws + OFF_H), DFF, (const u16*)(p.ws + OFF_WF2) + (size_t)l * 1024 * DFF,
                            nullptr, p.ln1_g + l * 1024, p.ln1_b + l * 1024, smem); break;
      case 8: if (PH_MASK & (2<<8)) phase_ln(p, p.ln2_g + l * 1024, p.ln2_b + l * 1024, l == 1); break;
    }
  }
}

extern "C" void kernel_launch(void* const* d_in, const int* in_sizes, int n_in, void* d_out, int out_size, void* d_ws,
                              size_t ws_size, hipStream_t stream) {
  static int grid_blocks = 0;
  if (!grid_blocks) {
    int dev = 0, cus = 0, per_cu = 0;
    hipGetDevice(&dev);
    hipDeviceGetAttribute(&cus, hipDeviceAttributeMultiprocessorCount, dev);
    hipOccupancyMaxActiveBlocksPerMultiprocessor(&per_cu, mega, 256, 0);
    if (per_cu < 1) per_cu = 1;
    if (per_cu > 2) per_cu = 2;
    grid_blocks = (cus * per_cu) & ~7;
    if (grid_blocks < 8) grid_blocks = 8;
  }
  if (ws_size < OFF_END) fprintf(stderr, "workspace too small: %zu < %zu\n", ws_size, (size_t)OFF_END);
  Params p{};
  p.x = (const float*)d_in[0]; p.w_in = (const float*)d_in[1]; p.conv_w = (const float*)d_in[2];
  p.w_conv_out = (const float*)d_in[3]; p.cmp_pos = (const float*)d_in[4]; p.cmp_w1 = (const float*)d_in[5];
  p.cmp_b1 = (const float*)d_in[6]; p.cmp_w2 = (const float*)d_in[7]; p.w_o = (const float*)d_in[8];
  p.ln1_g = (const float*)d_in[9]; p.ln1_b = (const float*)d_in[10]; p.w_ffn_in = (const float*)d_in[11];
  p.w_ffn_out = (const float*)d_in[12]; p.ln2_g = (const float*)d_in[13]; p.ln2_b = (const float*)d_in[14];
  p.out = (float*)d_out; p.ws = (char*)d_ws;
  hipMemsetAsync((char*)d_ws + OFF_BAR, 0, 16384, stream);
#if ONE_LAUNCH
  p.phase_begin = 0; p.phase_end = 19;
  void* args[] = {&p};
  hipError_t e = hipLaunchCooperativeKernel((void*)mega, dim3(grid_blocks), dim3(256), args, 0, stream);
  if (e != hipSuccess) fprintf(stderr, "cooperative launch failed: %s (grid %d)\n", hipGetErrorString(e), grid_blocks);
#else
  for (int ph = 0; ph < 19; ++ph) {
    p.phase_begin = ph; p.phase_end = ph + 1;
    mega<<<grid_blocks, 256, 0, stream>>>(p);
  }
#endif
}
```

```cpp
#include <hip/hip_runtime.h>
#include <hip/hip_cooperative_groups.h>
#include <cstdio>
#include <cstdint>
namespace cg = cooperative_groups;

#ifndef PH_MASK
#define PH_MASK 0xFFFF
#endif
#ifndef REP_MASK
#define REP_MASK 0
#endif
#ifndef ONE_LAUNCH
#define ONE_LAUNCH 1
#endif

typedef __attribute__((ext_vector_type(8))) short bf16x8;
typedef __attribute__((ext_vector_type(4))) float f32x4;
typedef __attribute__((ext_vector_type(2))) __bf16 bf16v2;
typedef unsigned short u16;
typedef __attribute__((ext_vector_type(4))) unsigned u32x4;
typedef __attribute__((ext_vector_type(2))) unsigned u32x2;

constexpr int T_ = 32768, S_ = 8192, D_ = 1024, NIN = 6192, DFF = 2816;
constexpr int N1 = 4224;
constexpr float ALPHA = 1.4142135623730951f;
constexpr float LOG2E = 1.4426950408889634f;

constexpr size_t MiB = 1ull << 20;
constexpr size_t OFF_WIN = 0;
constexpr size_t OFF_WMG = OFF_WIN + 2ull * N1 * 1024 * 2;
constexpr size_t OFF_WCO = OFF_WMG + 2ull * 2048 * 1024 * 2;
constexpr size_t OFF_WO  = OFF_WCO + 2ull * 1024 * 512 * 2;
constexpr size_t OFF_WF1 = OFF_WO  + 2ull * 1024 * 1024 * 2;
constexpr size_t OFF_WF2 = OFF_WF1 + 2ull * 5632 * 1024 * 2;
constexpr size_t OFF_WC1 = OFF_WF2 + 2ull * 1024 * 2816 * 2;
constexpr size_t OFF_WC2 = OFF_WC1 + 4ull * 128 * 2048 * 2;
constexpr size_t OFF_PB  = OFF_WC2 + 4ull * 64 * 128 * 2;
constexpr size_t OFF_KCMP = OFF_PB + 4096;
constexpr size_t OFF_VCMP = OFF_KCMP + 16ull * 512 * 64 * 2;
constexpr size_t OFF_GATE = OFF_VCMP + 16ull * 512 * 64 * 2;
constexpr size_t OFF_XB   = OFF_GATE + (size_t)T_ * 48 * 4;
constexpr size_t OFF_BV   = OFF_XB + (size_t)T_ * 1024 * 2;
constexpr size_t OFF_BCX  = OFF_BV + (size_t)T_ * 512 * 2;
constexpr size_t OFF_Q    = OFF_BCX + (size_t)T_ * 1536 * 2;
constexpr size_t OFF_KCVC = OFF_Q + (size_t)T_ * 1024 * 2;
constexpr size_t OFF_KSW  = OFF_KCVC + (size_t)T_ * 512 * 2;
constexpr size_t OFF_VST  = OFF_KSW + (size_t)T_ * 512 * 2;
constexpr size_t OFF_VWT  = OFF_VST + 16ull * 64 * S_ * 2;
constexpr size_t OFF_STAT = OFF_VWT + 16ull * 64 * S_ * 2;
constexpr size_t OFF_BAR  = OFF_STAT + (size_t)T_ * 8;
constexpr size_t OFF_END  = OFF_BAR + 16384;
constexpr size_t OFF_ATT  = OFF_BCX;
constexpr size_t OFF_MRG  = OFF_Q;
constexpr size_t OFF_H    = OFF_BCX;
static_assert(OFF_BCX + (size_t)T_ * DFF * 2 <= OFF_END, "h alias");
static_assert(OFF_END <= 512 * MiB, "ws");

struct Params {
  const float *x, *w_in, *conv_w, *w_conv_out, *cmp_pos, *cmp_w1, *cmp_b1, *cmp_w2, *w_o,
      *ln1_g, *ln1_b, *w_ffn_in, *w_ffn_out, *ln2_g, *ln2_b;
  float* out;
  char* ws;
  int phase_begin, phase_end;
};

constexpr int SMEM_BYTES = 73728;
constexpr int NRM_WORD = 3700;

__device__ __forceinline__ int otid() { int t = threadIdx.x; asm volatile("" : "+v"(t)); return t; }
__device__ __forceinline__ char* optr(char* q) { size_t z = 0; asm volatile("" : "+s"(z)); return q + z; }
__device__ __forceinline__ unsigned pack2(float a, float b) {
  bf16v2 v; v[0] = (__bf16)a; v[1] = (__bf16)b;
  return *reinterpret_cast<unsigned*>(&v);
}
__device__ __forceinline__ u16 f2bf(float a) { __bf16 v = (__bf16)a; return *reinterpret_cast<u16*>(&v); }
__device__ __forceinline__ float bf2f(unsigned h) { return __uint_as_float(h << 16); }
__device__ __forceinline__ float bflo(unsigned u) { return __uint_as_float(u << 16); }
__device__ __forceinline__ float bfhi(unsigned u) { return __uint_as_float(u & 0xFFFF0000u); }
__device__ __forceinline__ float sigmoidf_(float x) { return __builtin_amdgcn_rcpf(1.f + __expf(-x)); }
__device__ __forceinline__ f32x4 mfma16(bf16x8 a, bf16x8 b, f32x4 c) {
  return __builtin_amdgcn_mfma_f32_16x16x32_bf16(a, b, c, 0, 0, 0);
}

struct GUnit {
  const u16* A; const u16* B;
  unsigned aoff[4], boff[4];
  int akstep, nkt, m0, n0, step;
};
struct GPre { u32x4 a0[4], b0[4], a1[4], b1[4]; };

__device__ __forceinline__ void gemm_issue(GPre& r, const GUnit& u) {
#pragma unroll
  for (int j = 0; j < 4; ++j) {
    r.a0[j] = *reinterpret_cast<const u32x4*>(u.A + u.aoff[j]);
    r.b0[j] = *reinterpret_cast<const u32x4*>(u.B + u.boff[j]);
  }
#pragma unroll
  for (int j = 0; j < 4; ++j) {
    r.a1[j] = *reinterpret_cast<const u32x4*>(u.A + u.aoff[j] + (size_t)u.akstep);
    r.b1[j] = *reinterpret_cast<const u32x4*>(u.B + u.boff[j] + 64);
  }
}

template <class Next>
__device__ __forceinline__ void gemm_run(GPre& r, const GUnit& u, f32x4 (&acc)[4][4], char* smem, Next next) {
  const int tid = otid(), lane = tid & 63, w = tid >> 6, l15 = lane & 15, g4 = lane >> 4;
  const int wr = w >> 1, wc = w & 1;
  const int st_off = (tid >> 3) * 128 + ((((tid & 7) ^ ((tid >> 3) & 7))) << 4);
  const int rb = tid >> 3;
  const int rbp = (((rb >> 2) & 1) << 4) | (((rb >> 4) & 1) << 3) | (((rb >> 3) & 1) << 2) | (rb & 3);
  const int stb_off = 16384 + rbp * 128 + ((((tid & 7) ^ (rbp & 7))) << 4);
  const u16* A = u.A; const u16* B = u.B;
  const int akstep = u.akstep, nkt = u.nkt;
#pragma unroll
  for (int i = 0; i < 4; ++i)
#pragma unroll
    for (int j = 0; j < 4; ++j) acc[i][j] = f32x4{0.f, 0.f, 0.f, 0.f};
  auto ld0 = [&](int kt) {
    const size_t ka = (size_t)kt * akstep, kb = (size_t)kt * 64;
#pragma unroll
    for (int j = 0; j < 4; ++j) {
      r.a0[j] = *reinterpret_cast<const u32x4*>(A + u.aoff[j] + ka);
      r.b0[j] = *reinterpret_cast<const u32x4*>(B + u.boff[j] + kb);
    }
  };
  auto ld1 = [&](int kt) {
    const size_t ka = (size_t)kt * akstep, kb = (size_t)kt * 64;
#pragma unroll
    for (int j = 0; j < 4; ++j) {
      r.a1[j] = *reinterpret_cast<const u32x4*>(A + u.aoff[j] + ka);
      r.b1[j] = *reinterpret_cast<const u32x4*>(B + u.boff[j] + kb);
    }
  };
  auto st0 = [&](char* dst) {
#pragma unroll
    for (int j = 0; j < 4; ++j) {
      *reinterpret_cast<u32x4*>(dst + st_off + j * 4096) = r.a0[j];
      *reinterpret_cast<u32x4*>(dst + stb_off + j * 4096) = r.b0[j];
    }
  };
  auto st1 = [&](char* dst) {
#pragma unroll
    for (int j = 0; j < 4; ++j) {
      *reinterpret_cast<u32x4*>(dst + st_off + j * 4096) = r.a1[j];
      *reinterpret_cast<u32x4*>(dst + stb_off + j * 4096) = r.b1[j];
    }
  };
  auto compute = [&](const char* As) {
    const char* Bs = As + 16384;
    bf16x8 af[2][4], bfr[2][4];
#pragma unroll
    for (int ks = 0; ks < 2; ++ks) {
      const int coff = (((ks * 4 + g4) ^ (l15 & 7)) << 4);
#pragma unroll
      for (int mt = 0; mt < 4; ++mt)
        af[ks][mt] = *reinterpret_cast<const bf16x8*>(As + (wr * 64 + mt * 16 + l15) * 128 + coff);
#pragma unroll
      for (int nt = 0; nt < 4; ++nt)
        bfr[ks][nt] = *reinterpret_cast<const bf16x8*>(Bs + (wc * 64 + nt * 16 + l15) * 128 + coff);
    }
#pragma unroll
    for (int ks = 0; ks < 2; ++ks)
#pragma unroll
      for (int mt = 0; mt < 4; ++mt)
#pragma unroll
        for (int nt = 0; nt < 4; ++nt) acc[mt][nt] = mfma16(bfr[ks][nt], af[ks][mt], acc[mt][nt]);
  };
#define SGB(mask, n) __builtin_amdgcn_sched_group_barrier(mask, n, 0)
#define SGB_LOADS() SGB(0x008, 1); SGB(0x020, 1); SGB(0x008, 1); SGB(0x100, 1);
#define SGB_WRITES() SGB(0x008, 1); SGB(0x200, 1); SGB(0x008, 1);
#define SCHED_TILE()                                                                              \
  SGB(0x100, 8);                                                                                  \
  SGB_LOADS() SGB_LOADS() SGB_LOADS() SGB_LOADS() SGB_LOADS() SGB_LOADS() SGB_LOADS() SGB_LOADS() \
  SGB_WRITES() SGB_WRITES() SGB_WRITES() SGB_WRITES() SGB_WRITES() SGB_WRITES() SGB_WRITES() SGB_WRITES()
  st0(smem);
  __syncthreads();
#pragma unroll 1
  for (int kt = 0; kt < nkt - 2; kt += 2) {
    __builtin_amdgcn_s_setprio(1);
    ld0(kt + 2);
    compute(smem);
    st1(smem + 32768);
    SCHED_TILE()
    __builtin_amdgcn_s_setprio(0);
    __syncthreads();
    __builtin_amdgcn_s_setprio(1);
    ld1(kt + 3);
    compute(smem + 32768);
    st0(smem);
    SCHED_TILE()
    __builtin_amdgcn_s_setprio(0);
    __syncthreads();
  }
  GUnit nu;
  next(nu);
  __builtin_amdgcn_s_setprio(1);
#pragma unroll
  for (int j = 0; j < 4; ++j) {
    r.a0[j] = *reinterpret_cast<const u32x4*>(nu.A + nu.aoff[j]);
    r.b0[j] = *reinterpret_cast<const u32x4*>(nu.B + nu.boff[j]);
  }
  compute(smem);
  st1(smem + 32768);
  SCHED_TILE()
  __builtin_amdgcn_s_setprio(0);
  __syncthreads();
  __builtin_amdgcn_s_setprio(1);
#pragma unroll
  for (int j = 0; j < 4; ++j) {
    r.a1[j] = *reinterpret_cast<const u32x4*>(nu.A + nu.aoff[j] + (size_t)nu.akstep);
    r.b1[j] = *reinterpret_cast<const u32x4*>(nu.B + nu.boff[j] + 64);
  }
  compute(smem + 32768);
  SGB(0x100, 8);
  SGB_LOADS() SGB_LOADS() SGB_LOADS() SGB_LOADS() SGB_LOADS() SGB_LOADS() SGB_LOADS() SGB_LOADS()
  __builtin_amdgcn_s_setprio(0);
  __syncthreads();
#undef SCHED_TILE
#undef SGB_WRITES
#undef SGB_LOADS
#undef SGB
}

__device__ __forceinline__ void std_offsets(unsigned (&off)[4], int r0, int ld) {
  const int tid = otid();
#pragma unroll
  for (int j = 0; j < 4; ++j) off[j] = (unsigned)(r0 + (tid >> 3) + 32 * j) * (unsigned)ld + (tid & 7) * 8;
}

template <int NSTEPS, class Setup, class Epi>
__device__ __forceinline__ void gemm_stream(int NT, Setup setup, Epi epi, char* smem) {
  const int xcd = blockIdx.x & 7, lb = blockIdx.x >> 3, nlb = gridDim.x >> 3, total = 32 * NT;
  int s = lb, step = 0;
  if (s >= total) return;
  GUnit cur;
  GPre pre;
  auto mk = [&](GUnit& u, int s_, int step_) {
    const int grp = s_ / (8 * NT), wv = s_ % (8 * NT);
    u.m0 = ((xcd * 4 + grp) * 8 + (wv & 7)) * 128;
    u.n0 = (wv >> 3) * 128;
    u.step = step_;
    setup(u);
  };
  mk(cur, s, 0);
  gemm_issue(pre, cur);
#pragma unroll 1
  while (true) {
    f32x4 acc[4][4];
    int ns = s, nstep = step + 1;
    if (nstep == NSTEPS) { nstep = 0; ns = s + nlb; }
    const bool has = ns < total;
    if (!has) { ns = s; nstep = step; }
    gemm_run(pre, cur, acc, smem, [&](GUnit& nu) { mk(nu, ns, nstep); });
    epi(cur, acc);
    if (!has) break;
    mk(cur, ns, nstep);
    s = ns; step = nstep;
  }
}

__device__ __forceinline__ void transpose_job(const float* __restrict__ src, int ld, int K, int N, int mode, u16* __restrict__ dst,
                              char* smem) {
  float* t = reinterpret_cast<float*>(smem);
  const int tid = otid(), tx = tid & 31, ty = tid >> 5;
  const int ntn = N / 32, ntk = K / 64;
  for (int tile = blockIdx.x; tile < ntn * ntk; tile += gridDim.x) {
    const int n0 = (tile % ntn) * 32, k0 = (tile / ntn) * 64;
    const int n = n0 + tx;
    int sc;
    if (mode == 0) sc = n;
    else if (mode == 1) sc = (n < 4144) ? n : -1;
    else if (mode == 2) sc = 4144 + n;
    else sc = ((n & 63) < 32) ? ((n >> 6) * 32 + (n & 63)) : (DFF + (n >> 6) * 32 + (n & 63) - 32);
#pragma unroll
    for (int i = 0; i < 8; ++i) {
      const int k = k0 + ty + 8 * i;
      t[(ty + 8 * i) * 33 + tx] = (sc >= 0) ? src[(size_t)k * ld + sc] : 0.f;
    }
    __syncthreads();
#pragma unroll
    for (int i = 0; i < 4; ++i) {
      const int nn = ty + 8 * i;
      const unsigned v = pack2(t[(2 * tx) * 33 + nn], t[(2 * tx + 1) * 33 + nn]);
      *reinterpret_cast<unsigned*>(dst + (size_t)(n0 + nn) * K + k0 + 2 * tx) = v;
    }
    __syncthreads();
  }
}

__device__ __forceinline__ void phase_prologue(const Params& p, char* smem) {
  char* ws = optr(p.ws);
  for (int l = 0; l < 2; ++l) {
    transpose_job(p.w_in + (size_t)l * D_ * NIN, NIN, 1024, N1, 1, (u16*)(ws + OFF_WIN) + (size_t)l * N1 * 1024, smem);
    transpose_job(p.w_in + (size_t)l * D_ * NIN, NIN, 1024, 2048, 2, (u16*)(ws + OFF_WMG) + (size_t)l * 2048 * 1024, smem);
    transpose_job(p.w_conv_out + (size_t)l * 512 * 1024, 1024, 512, 1024, 0, (u16*)(ws + OFF_WCO) + (size_t)l * 1024 * 512, smem);
    transpose_job(p.w_o + (size_t)l * 1024 * 1024, 1024, 1024, 1024, 0, (u16*)(ws + OFF_WO) + (size_t)l * 1024 * 1024, smem);
    transpose_job(p.w_ffn_in + (size_t)l * 1024 * 5632, 5632, 1024, 5632, 3, (u16*)(ws + OFF_WF1) + (size_t)l * 5632 * 1024, smem);
    transpose_job(p.w_ffn_out + (size_t)l * DFF * 1024, 1024, DFF, 1024, 0, (u16*)(ws + OFF_WF2) + (size_t)l * 1024 * DFF, smem);
    for (int kv = 0; kv < 2; ++kv) {
      transpose_job(p.cmp_w1 + (size_t)(l * 2 + kv) * 2048 * 128, 128, 2048, 128, 0, (u16*)(ws + OFF_WC1) + (size_t)(l * 2 + kv) * 128 * 2048, smem);
      transpose_job(p.cmp_w2 + (size_t)(l * 2 + kv) * 128 * 64, 64, 128, 64, 0, (u16*)(ws + OFF_WC2) + (size_t)(l * 2 + kv) * 64 * 128, smem);
    }
  }
  const int gtid = blockIdx.x * 256 + otid(), gsz = gridDim.x * 256;
  {
    u16* xb = (u16*)(ws + OFF_XB);
    for (size_t i = gtid; i < (size_t)T_ * D_ / 8; i += gsz) {
      const float4 a = reinterpret_cast<const float4*>(p.x)[2 * i], b = reinterpret_cast<const float4*>(p.x)[2 * i + 1];
      uint4 o; o.x = pack2(a.x, a.y); o.y = pack2(a.z, a.w); o.z = pack2(b.x, b.y); o.w = pack2(b.z, b.w);
      reinterpret_cast<uint4*>(xb)[i] = o;
    }
  }
  {
    const int gw = gtid >> 6, lane = otid() & 63;
    if (gw < 512) {
      const int lk = gw >> 7, n = gw & 127;
      const float* pos = p.cmp_pos + (size_t)lk * 2048;
      const float* w1 = p.cmp_w1 + (size_t)lk * 2048 * 128;
      float s = 0.f;
      for (int k = lane; k < 2048; k += 64) s += pos[k] * w1[(size_t)k * 128 + n];
      for (int o = 32; o > 0; o >>= 1) s += __shfl_xor(s, o);
      if (lane == 0) reinterpret_cast<float*>(ws + OFF_PB)[gw] = s + p.cmp_b1[lk * 128 + n];
    }
  }
  if (gtid < 16 * 64) {
    const int bg = gtid >> 6, d = gtid & 63;
    ((u16*)(ws + OFF_KCMP))[((size_t)bg * 512 + 511) * 64 + d] = 0;
    ((u16*)(ws + OFF_VCMP))[((size_t)bg * 64 + d) * 512 + 511] = 0;
  }
}

__device__ __forceinline__ void phase_gemm1(const Params& p, int l, char* smem) {
  char* ws = optr(p.ws);
  const u16* A = (const u16*)(ws + OFF_XB);
  const u16* B = (const u16*)(ws + OFF_WIN) + (size_t)l * N1 * 1024;
  const int tid = otid(), lane = tid & 63, w = tid >> 6, l15 = lane & 15, g4 = lane >> 4, wr = w >> 1, wc = w & 1;
  auto setup = [&](GUnit& u) {
    u.A = A; u.B = B; u.akstep = 64; u.nkt = 16;
    std_offsets(u.aoff, u.m0, 1024); std_offsets(u.boff, u.n0, 1024);
  };
  auto epi = [&](const GUnit& u, f32x4 (&acc)[4][4]) {
    const int m0 = u.m0, n0 = u.n0, nt_ = u.n0 >> 7;
    const int ntype = (nt_ >= 12 && nt_ < 20) ? 0 : (nt_ == 24 || nt_ == 25) ? 1 : (nt_ == 28 || nt_ == 29) ? 2 : -1;
    float wmax = 0.f;
#pragma unroll
    for (int mt = 0; mt < 4; ++mt) {
      const int m = m0 + wr * 64 + mt * 16 + l15;
      float rowsq = 0.f;
#pragma unroll
      for (int np = 0; np < 2; ++np) {
        const int n = n0 + wc * 64 + np * 32 + g4 * 8;
        const f32x4 v0 = acc[mt][2 * np], v1 = acc[mt][2 * np + 1];
        rowsq += v0[0] * v0[0] + v0[1] * v0[1] + v0[2] * v0[2] + v0[3] * v0[3] + v1[0] * v1[0] + v1[1] * v1[1] + v1[2] * v1[2] + v1[3] * v1[3];
        if (nt_ < 12) {
          u32x4 o; o[0] = pack2(v0[0], v0[1]); o[1] = pack2(v0[2], v0[3]); o[2] = pack2(v1[0], v1[1]); o[3] = pack2(v1[2], v1[3]);
          *reinterpret_cast<u32x4*>((u16*)(ws + OFF_BCX) + (size_t)m * 1536 + n) = o;
        } else if (nt_ < 20) {
          const float sc = 0.125f * LOG2E;
          u32x4 o; o[0] = pack2(v0[0] * sc, v0[1] * sc); o[1] = pack2(v0[2] * sc, v0[3] * sc);
          o[2] = pack2(v1[0] * sc, v1[1] * sc); o[3] = pack2(v1[2] * sc, v1[3] * sc);
          *reinterpret_cast<u32x4*>((u16*)(ws + OFF_Q) + (size_t)m * 1024 + (n - 1536)) = o;
        } else if (nt_ < 24) {
          u32x4 o; o[0] = pack2(v0[0], v0[1]); o[1] = pack2(v0[2], v0[3]); o[2] = pack2(v1[0], v1[1]); o[3] = pack2(v1[2], v1[3]);
          *reinterpret_cast<u32x4*>((u16*)(ws + OFF_KCVC) + (size_t)m * 512 + (n - 2560)) = o;
        } else if (nt_ < 26 || nt_ == 28 || nt_ == 29) {
          const int c = (nt_ < 26) ? (n - 3072) : (256 + n - 3584);
          u32x4 o; o[0] = pack2(v0[0], v0[1]); o[1] = pack2(v0[2], v0[3]); o[2] = pack2(v1[0], v1[1]); o[3] = pack2(v1[2], v1[3]);
          *reinterpret_cast<u32x4*>((u16*)(ws + OFF_KSW) + (size_t)m * 512 + c) = o;
        } else if (nt_ < 32) {
          const int c = (nt_ < 28) ? (n - 3328) : (n - 3840);
          u16* vt = (u16*)(ws + ((nt_ < 28) ? OFF_VST : OFF_VWT));
          const int b = m >> 13, sp = m & (S_ - 1), g = c >> 6, d = c & 63;
#pragma unroll
          for (int j = 0; j < 4; ++j) {
            vt[((size_t)((b * 4 + g) * 64 + d + j)) * S_ + sp] = f2bf(v0[j]);
            vt[((size_t)((b * 4 + g) * 64 + d + 4 + j)) * S_ + sp] = f2bf(v1[j]);
          }
        } else {
          const int c = n - 4096;
          if (c < 48) {
            float4 o; o.x = sigmoidf_(v0[0]); o.y = sigmoidf_(v0[1]); o.z = sigmoidf_(v0[2]); o.w = sigmoidf_(v0[3]);
            float4 o1; o1.x = sigmoidf_(v1[0]); o1.y = sigmoidf_(v1[1]); o1.z = sigmoidf_(v1[2]); o1.w = sigmoidf_(v1[3]);
            float* gp = (float*)(ws + OFF_GATE) + (size_t)m * 48 + c;
            *reinterpret_cast<float4*>(gp) = o;
            *reinterpret_cast<float4*>(gp + 4) = o1;
          }
        }
      }
      if (ntype >= 0) {
        rowsq += __shfl_xor(rowsq, 16);
        rowsq += __shfl_xor(rowsq, 32);
        wmax = fmaxf(wmax, rowsq);
      }
    }
    if (ntype >= 0) {
#pragma unroll
      for (int o = 1; o < 16; o <<= 1) wmax = fmaxf(wmax, __shfl_xor(wmax, o));
      if (ntype == 0) wmax *= (0.125f * LOG2E) * (0.125f * LOG2E);
      if (lane == 0) atomicMax((unsigned*)(ws + OFF_BAR) + NRM_WORD + l * 4 + ntype, __float_as_uint(wmax));
    }
  };
  gemm_stream<1>(33, setup, epi, smem);
}

__device__ __forceinline__ float gelu_tanh(float x) {
  const float u = 0.7978845608028654f * (x + 0.044715f * x * x * x);
  const float e = __expf(2.f * u);
  const float th = 1.f - 2.f / (e + 1.f);
  return 0.5f * x * (1.f + th);
}

__device__ __forceinline__ void compress_tile(const Params& p, int l, int kv, int mtile, char* smem) {
  char* ws = optr(p.ws);
  const int tid = otid(), lane = tid & 63, w = tid >> 6, l15 = lane & 15, g4 = lane >> 4, wr = w >> 1, wc = w & 1;
  const u16* A = (const u16*)(ws + OFF_KCVC);
  const u16* B = (const u16*)(ws + OFF_WC1) + (size_t)(l * 2 + kv) * 128 * 2048;
  unsigned aoff[4], boff[4];
#pragma unroll
  for (int j = 0; j < 4; ++j) {
    int r = mtile * 128 + (tid >> 3) + 32 * j;
    r = r < 8176 ? r : 8175;
    const int bg = r / 511, i = r - bg * 511;
    const int b = bg >> 2, g = bg & 3;
    aoff[j] = (unsigned)(b * S_ + 16 * i) * 512u + kv * 256 + g * 64 + (tid & 7) * 8;
  }
  std_offsets(boff, 0, 2048);
  f32x4 acc[4][4];
  {
    GUnit u; GPre pre;
    u.A = A; u.B = B; u.akstep = 512; u.nkt = 32; u.m0 = 0; u.n0 = 0; u.step = 0;
#pragma unroll
    for (int j = 0; j < 4; ++j) { u.aoff[j] = aoff[j]; u.boff[j] = boff[j]; }
    gemm_issue(pre, u);
    gemm_run(pre, u, acc, smem, [&](GUnit& nu) { nu = u; });
  }
  const float* pb = reinterpret_cast<const float*>(ws + OFF_PB) + (l * 2 + kv) * 128;
#pragma unroll
  for (int mt = 0; mt < 4; ++mt) {
    const int m = wr * 64 + mt * 16 + l15;
#pragma unroll
    for (int np = 0; np < 2; ++np) {
      const int n = wc * 64 + np * 32 + g4 * 8;
      const float4 b0 = *reinterpret_cast<const float4*>(pb + n);
      const float4 b1 = *reinterpret_cast<const float4*>(pb + n + 4);
      const f32x4 v0 = acc[mt][2 * np], v1 = acc[mt][2 * np + 1];
      u32x4 o;
      o[0] = pack2(gelu_tanh(v0[0] + b0.x), gelu_tanh(v0[1] + b0.y));
      o[1] = pack2(gelu_tanh(v0[2] + b0.z), gelu_tanh(v0[3] + b0.w));
      o[2] = pack2(gelu_tanh(v1[0] + b1.x), gelu_tanh(v1[1] + b1.y));
      o[3] = pack2(gelu_tanh(v1[2] + b1.z), gelu_tanh(v1[3] + b1.w));
      const int ch = n >> 3;
      *reinterpret_cast<u32x4*>(smem + m * 256 + (((ch ^ (m & 7))) << 4)) = o;
    }
  }
  __syncthreads();
  const u16* W2 = (const u16*)(ws + OFF_WC2) + (size_t)(l * 2 + kv) * 64 * 128;
  f32x4 a2[2][4];
#pragma unroll
  for (int i = 0; i < 2; ++i)
#pragma unroll
    for (int j = 0; j < 4; ++j) a2[i][j] = f32x4{0.f, 0.f, 0.f, 0.f};
#pragma unroll
  for (int ks = 0; ks < 4; ++ks) {
    bf16x8 af[2], bfr[4];
#pragma unroll
    for (int i = 0; i < 2; ++i) {
      const int m = w * 32 + i * 16 + l15;
      af[i] = *reinterpret_cast<const bf16x8*>(smem + m * 256 + ((((ks * 4 + g4) ^ (m & 7))) << 4));
    }
#pragma unroll
    for (int nt = 0; nt < 4; ++nt)
      bfr[nt] = *reinterpret_cast<const bf16x8*>(W2 + (nt * 16 + l15) * 128 + ks * 32 + g4 * 8);
#pragma unroll
    for (int i = 0; i < 2; ++i)
#pragma unroll
      for (int nt = 0; nt < 4; ++nt) a2[i][nt] = mfma16(bfr[nt], af[i], a2[i][nt]);
  }
  if (kv == 0) {
    float wmax = 0.f;
#pragma unroll
    for (int i = 0; i < 2; ++i) {
      const int r = mtile * 128 + w * 32 + i * 16 + l15;
      float rowsq = 0.f;
#pragma unroll
      for (int nt = 0; nt < 4; ++nt)
#pragma unroll
        for (int j = 0; j < 4; ++j) rowsq += a2[i][nt][j] * a2[i][nt][j];
      rowsq += __shfl_xor(rowsq, 16);
      rowsq += __shfl_xor(rowsq, 32);
      wmax = fmaxf(wmax, r < 8176 ? rowsq : 0.f);
    }
#pragma unroll
    for (int o = 1; o < 16; o <<= 1) wmax = fmaxf(wmax, __shfl_xor(wmax, o));
    if (lane == 0) atomicMax((unsigned*)(ws + OFF_BAR) + NRM_WORD + l * 4 + 3, __float_as_uint(wmax));
  }
#pragma unroll
  for (int i = 0; i < 2; ++i) {
    const int r = mtile * 128 + w * 32 + i * 16 + l15;
    if (r < 8176) {
      const int bg = r / 511, c = r - bg * 511;
#pragma unroll
      for (int nt = 0; nt < 4; ++nt) {
        const int d = nt * 16 + g4 * 4;
        if (kv == 0) {
          uint2 o; o.x = pack2(a2[i][nt][0], a2[i][nt][1]); o.y = pack2(a2[i][nt][2], a2[i][nt][3]);
          *reinterpret_cast<uint2*>((u16*)(ws + OFF_KCMP) + ((size_t)bg * 512 + c) * 64 + d) = o;
        } else {
#pragma unroll
          for (int j = 0; j < 4; ++j)
            ((u16*)(ws + OFF_VCMP))[((size_t)bg * 64 + d + j) * 512 + c] = f2bf(a2[i][nt][j]);
        }
      }
    }
  }
  __syncthreads();
}

__device__ __forceinline__ void phase_conv_compress(const Params& p, int l, char* smem) {
  char* ws = optr(p.ws);
  for (int t = blockIdx.x; t < 128; t += gridDim.x) compress_tile(p, l, t >> 6, t & 63, smem);
  const u16* bcx = (const u16*)(ws + OFF_BCX);
  u16* bv = (u16*)(ws + OFF_BV);
  const float* cw = p.conv_w + (size_t)l * 3 * 512;
  const int cb0 = (gridDim.x >= 256) ? 128 : 0;
  if ((int)blockIdx.x < cb0) return;
  for (size_t idx = (size_t)(blockIdx.x - cb0) * 256 + otid(); idx < (size_t)T_ * 64; idx += (size_t)(gridDim.x - cb0) * 256) {
    const int t = (int)(idx >> 6), c0 = (int)(idx & 63) * 8;
    const int s = t & (S_ - 1);
    float v[8];
#pragma unroll
    for (int i = 0; i < 8; ++i) v[i] = 0.f;
#pragma unroll
    for (int k = 0; k < 3; ++k) {
      const int dt = 2 - k;
      if (s - dt >= 0) {
        const uint4 cc = *reinterpret_cast<const uint4*>(bcx + (size_t)(t - dt) * 1536 + 512 + c0);
        const uint4 xx = *reinterpret_cast<const uint4*>(bcx + (size_t)(t - dt) * 1536 + 1024 + c0);
        const float4 w0 = *reinterpret_cast<const float4*>(cw + k * 512 + c0);
        const float4 w1 = *reinterpret_cast<const float4*>(cw + k * 512 + c0 + 4);
        v[0] += w0.x * bflo(cc.x) * bflo(xx.x); v[1] += w0.y * bfhi(cc.x) * bfhi(xx.x);
        v[2] += w0.z * bflo(cc.y) * bflo(xx.y); v[3] += w0.w * bfhi(cc.y) * bfhi(xx.y);
        v[4] += w1.x * bflo(cc.z) * bflo(xx.z); v[5] += w1.y * bfhi(cc.z) * bfhi(xx.z);
        v[6] += w1.z * bflo(cc.w) * bflo(xx.w); v[7] += w1.w * bfhi(cc.w) * bfhi(xx.w);
      }
    }
    const uint4 bb = *reinterpret_cast<const uint4*>(bcx + (size_t)t * 1536 + c0);
    uint4 o;
    o.x = pack2(v[0] * bflo(bb.x), v[1] * bfhi(bb.x));
    o.y = pack2(v[2] * bflo(bb.y), v[3] * bfhi(bb.y));
    o.z = pack2(v[4] * bflo(bb.z), v[5] * bfhi(bb.z));
    o.w = pack2(v[6] * bflo(bb.w), v[7] * bfhi(bb.w));
    *reinterpret_cast<uint4*>(bv + (size_t)t * 512 + c0) = o;
  }
}

constexpr int LDS_IMP = 32768;
constexpr int LDS_UNI = 32768 + 33024;
constexpr int LDS_CNT = LDS_UNI + 16;
constexpr int LDS_LIST = LDS_UNI + 32;

struct TileRegs { u32x4 k0, k1, v0, v1; };

__device__ __forceinline__ void attn_prefetch(TileRegs& r, const u16* Kb, size_t ldk, const u16* Vb, size_t ldv) {
  const int tid = otid();
  const int row = (tid >> 3), c = (tid & 7) * 8;
  r.k0 = *reinterpret_cast<const u32x4*>(Kb + row * ldk + c);
  r.k1 = *reinterpret_cast<const u32x4*>(Kb + (row + 32) * ldk + c);
  r.v0 = *reinterpret_cast<const u32x4*>(Vb + row * ldv + c);
  r.v1 = *reinterpret_cast<const u32x4*>(Vb + (row + 32) * ldv + c);
}
__device__ __forceinline__ void attn_stage(const TileRegs& r, char* buf) {
  const int tid = otid();
  const int off = (tid >> 3) * 128 + ((((tid & 7) ^ ((tid >> 3) & 7))) << 4);
  *reinterpret_cast<u32x4*>(buf + off) = r.k0;
  *reinterpret_cast<u32x4*>(buf + off + 4096) = r.k1;
  *reinterpret_cast<u32x4*>(buf + 8192 + off) = r.v0;
  *reinterpret_cast<u32x4*>(buf + 8192 + off + 4096) = r.v1;
}

template <int MODE, bool MASKED, bool SELECT>
__device__ __forceinline__ void attn_tile(const char* buf, const bf16x8 (&qf)[2][2], f32x4 (&O)[2][4], float (&lsum)[2],
                                          const float (&invl)[2], const float (&slope)[2], float x0, float stride,
                                          float wlimit, bool selected, float* impq, bool impacc,
                                          float& p3carry) {
  const int lane = otid() & 63, l15 = lane & 15, g4 = lane >> 4;
  f32x4 psum[4];
#pragma unroll
  for (int i = 0; i < 4; ++i) psum[i] = f32x4{0.f, 0.f, 0.f, 0.f};
  const char* Kl = buf;
  const char* Vl = buf + 8192;
  float e[4];
#pragma unroll
  for (int j = 0; j < 4; ++j) e[j] = stride * (float)(g4 * 4 + j);
  bf16x8 pf[2][2];
  {
    bf16x8 kf[4][2];
#pragma unroll
    for (int sub = 0; sub < 4; ++sub)
#pragma unroll
      for (int ks = 0; ks < 2; ++ks)
        kf[sub][ks] = *reinterpret_cast<const bf16x8*>(Kl + (sub * 16 + l15) * 128 + ((((ks * 4 + g4) ^ (l15 & 7))) << 4));
#pragma unroll
    for (int hh = 0; hh < 2; ++hh) {
      f32x4 s[4];
#pragma unroll
      for (int sub = 0; sub < 4; ++sub) {
        float xs = x0 + stride * 16.f * (float)sub;
        if (SELECT) xs = selected ? xs : -1e32f;
        f32x4 bias;
#pragma unroll
        for (int j = 0; j < 4; ++j) bias[j] = slope[hh] * (xs + e[j]);
        __builtin_amdgcn_s_setprio(1);
        s[sub] = mfma16(kf[sub][0], qf[hh][0], bias);
        s[sub] = mfma16(kf[sub][1], qf[hh][1], s[sub]);
        __builtin_amdgcn_s_setprio(0);
      }
      float ls = 0.f;
#pragma unroll
      for (int sub = 0; sub < 4; ++sub) {
        const float xs = x0 + stride * 16.f * (float)sub;
#pragma unroll
        for (int j = 0; j < 4; ++j) {
          float pv = __builtin_amdgcn_exp2f(s[sub][j]);
          if (MASKED) { const float dd = xs + e[j]; pv = (dd <= 0.f && dd > -wlimit) ? pv : 0.f; }
          if (MODE == 1) { pv *= invl[hh]; psum[sub][j] += pv; }
          else ls += pv;
          s[sub][j] = pv;
        }
      }
      if (MODE != 1) lsum[hh] += ls;
      if (MODE != 0) {
#pragma unroll
        for (int kk = 0; kk < 2; ++kk) {
          union { bf16x8 v; unsigned u[4]; } pk;
          pk.u[0] = pack2(s[2 * kk][0], s[2 * kk][1]);
          pk.u[1] = pack2(s[2 * kk][2], s[2 * kk][3]);
          pk.u[2] = pack2(s[2 * kk + 1][0], s[2 * kk + 1][1]);
          pk.u[3] = pack2(s[2 * kk + 1][2], s[2 * kk + 1][3]);
          pf[hh][kk] = pk.v;
        }
      }
    }
  }
  if (MODE != 0) {
#pragma unroll
    for (int dt = 0; dt < 4; ++dt) {
      const int d = dt * 16 + l15;
      bf16x8 vf[2];
#pragma unroll
      for (int kk = 0; kk < 2; ++kk) {
        union { bf16x8 v; uint2 u[2]; } vv;
        const int c0 = kk * 4 + (g4 >> 1);
        vv.u[0] = *reinterpret_cast<const uint2*>(Vl + d * 128 + (((c0 ^ (d & 7))) << 4) + (g4 & 1) * 8);
        vv.u[1] = *reinterpret_cast<const uint2*>(Vl + d * 128 + ((((c0 + 2) ^ (d & 7))) << 4) + (g4 & 1) * 8);
        vf[kk] = vv.v;
      }
      __builtin_amdgcn_s_setprio(1);
#pragma unroll
      for (int hh = 0; hh < 2; ++hh) {
        O[hh][dt] = mfma16(vf[0], pf[hh][0], O[hh][dt]);
        O[hh][dt] = mfma16(vf[1], pf[hh][1], O[hh][dt]);
      }
      __builtin_amdgcn_s_setprio(0);
    }
  }
  if (MODE == 1) {
    float prev3 = p3carry;
#pragma unroll
    for (int sub = 0; sub < 4; ++sub) {
      const float give = (g4 == 3) ? prev3 : psum[sub][3];
      const float carry = __shfl(give, (lane + 48) & 63);
      float* dst = impq + sub * 4 + g4;
      const float base = impacc ? *dst : 0.f;
      *dst = base + (psum[sub][0] + psum[sub][1] + psum[sub][2] + psum[sub][3] + carry);
      prev3 = psum[sub][3];
    }
    p3carry = prev3;
  }
}

__device__ __forceinline__ float red4(float v) {
  v += __shfl_xor(v, 16);
  v += __shfl_xor(v, 32);
  return v;
}

__device__ __forceinline__ void attn_item(const Params& p, int l, int b, int g, int qt, char* smem) {
  char* ws = optr(p.ws);
  const int tid = otid(), lane = tid & 63, w = tid >> 6, l15 = lane & 15, g4 = lane >> 4;
  const int q0 = qt * 64, ql = w * 16 + l15, tq = q0 + ql;
  const int bg = b * 4 + g;
  const u16* qb = (const u16*)(ws + OFF_Q);
  const u16* ksw = (const u16*)(ws + OFF_KSW);
  const u16* kcmp = (const u16*)(ws + OFF_KCMP) + (size_t)bg * 512 * 64;
  const u16* vcmp = (const u16*)(ws + OFF_VCMP) + (size_t)bg * 64 * 512;
  const u16* vst = (const u16*)(ws + OFF_VST) + (size_t)bg * 64 * S_;
  const u16* vwt = (const u16*)(ws + OFF_VWT) + (size_t)bg * 64 * S_;
  const float* gate = (const float*)(ws + OFF_GATE) + (size_t)(b * S_ + tq) * 48 + g * 12;
  u16* ao = (u16*)(ws + OFF_ATT) + (size_t)(b * S_ + tq) * 1024 + g * 256;
  float* imp = reinterpret_cast<float*>(smem + LDS_IMP);
  unsigned* uni = reinterpret_cast<unsigned*>(smem + LDS_UNI);
  int* cntp = reinterpret_cast<int*>(smem + LDS_CNT);
  int* list = reinterpret_cast<int*>(smem + LDS_LIST);

  bf16x8 qf[2][2];
  float slope[2], lsum[2], invl[2];
  f32x4 O[2][4];
  if (tid < 4) uni[tid] = 0u;
  for (int i = tid; i < 64 * 129; i += 256) imp[i] = 0.f;

  const int nct = (4 * qt + 3 + 63) >> 6;
  const int kb0 = qt >= 8 ? qt - 8 : 0;
  float sm_c, sm_w, sm_s;
  {
    unsigned* nw = (unsigned*)(ws + OFF_BAR) + NRM_WORD + l * 4;
    const float qn = sqrtf(__uint_as_float(__hip_atomic_load(nw + 0, __ATOMIC_RELAXED, __HIP_MEMORY_SCOPE_AGENT)));
    const float ksn = sqrtf(__uint_as_float(__hip_atomic_load(nw + 1, __ATOMIC_RELAXED, __HIP_MEMORY_SCOPE_AGENT)));
    const float kwn = sqrtf(__uint_as_float(__hip_atomic_load(nw + 2, __ATOMIC_RELAXED, __HIP_MEMORY_SCOPE_AGENT)));
    const float kcn = sqrtf(__uint_as_float(__hip_atomic_load(nw + 3, __ATOMIC_RELAXED, __HIP_MEMORY_SCOPE_AGENT)));
    sm_c = 152.f + 1.05f * qn * kcn; sm_w = 152.f + 1.05f * qn * kwn; sm_s = 152.f + 1.05f * qn * ksn;
  }
  int ct0 = 0, ncp = nct, kbs = kb0, nA = 2 * nct + (qt - kb0 + 1);
  auto set_cut = [&](float slope_min) {
    const float inv = 1.f / slope_min;
    const float xc = ((float)q0 - 1039.f - sm_c * inv) * (1.f / 1024.f);
    ct0 = xc > 0.f ? (int)ceilf(xc) : 0;
    ct0 = ct0 < nct - 1 ? ct0 : nct - 1;
    ncp = nct - ct0;
    const float xw = ((float)q0 - 63.f - sm_w * inv) * (1.f / 64.f);
    kbs = xw > 0.f ? (int)ceilf(xw) : 0;
    kbs = kbs > kb0 ? kbs : kb0;
    kbs = kbs < qt ? kbs : qt;
    nA = 2 * ncp + (qt - kbs + 1);
  };

  auto load_q = [&](int hp) {
#pragma unroll
    for (int hh = 0; hh < 2; ++hh) {
      const int h = hp * 2 + hh;
#pragma unroll
      for (int ks = 0; ks < 2; ++ks)
        qf[hh][ks] = *reinterpret_cast<const bf16x8*>(qb + (size_t)(b * S_ + tq) * 1024 + (g * 4 + h) * 64 + ks * 32 + g4 * 8);
      slope[hh] = exp2f(-0.5f * (float)(g * 4 + h + 1)) * LOG2E;
      lsum[hh] = 0.f; invl[hh] = 0.f;
#pragma unroll
      for (int dt = 0; dt < 4; ++dt) O[hh][dt] = f32x4{0.f, 0.f, 0.f, 0.f};
    }
  };
  auto srcA = [&](int e, const u16*& Kb, size_t& ldk, const u16*& Vb, size_t& ldv) {
    if (e < 2 * ncp) {
      const int ct = ct0 + (e < ncp ? e : e - ncp);
      Kb = kcmp + (size_t)ct * 64 * 64; ldk = 64; Vb = vcmp + ct * 64; ldv = 512;
    } else {
      const int pos0 = (kbs + e - 2 * ncp) * 64;
      Kb = ksw + (size_t)(b * S_ + pos0) * 512 + 256 + g * 64; ldk = 512; Vb = vwt + pos0; ldv = S_;
    }
  };
  auto fold = [&](int hp, int br) {
    u32x2 oldv[2][4];
#pragma unroll
    for (int hh = 0; hh < 2; ++hh)
#pragma unroll
      for (int dt = 0; dt < 4; ++dt) {
        oldv[hh][dt] = u32x2{0u, 0u};
        if (br != 0) oldv[hh][dt] = *reinterpret_cast<const u32x2*>(ao + (hp * 2 + hh) * 64 + dt * 16 + g4 * 4);
      }
#pragma unroll
    for (int hh = 0; hh < 2; ++hh) {
      const int h = hp * 2 + hh;
      float sc = gate[h * 3 + br];
      if (br != 0) { const float l = red4(lsum[hh]); sc *= (l > 0.f) ? 1.f / l : 0.f; }
#pragma unroll
      for (int dt = 0; dt < 4; ++dt) {
        const u32x2 old = oldv[hh][dt];
        const float a0 = bflo(old[0]) + sc * O[hh][dt][0], a1 = bfhi(old[0]) + sc * O[hh][dt][1];
        const float a2 = bflo(old[1]) + sc * O[hh][dt][2], a3 = bfhi(old[1]) + sc * O[hh][dt][3];
        u32x2 o; o[0] = pack2(a0, a1); o[1] = pack2(a2, a3);
        *reinterpret_cast<u32x2*>(ao + h * 64 + dt * 16 + g4 * 4) = o;
        O[hh][dt] = f32x4{0.f, 0.f, 0.f, 0.f};
      }
      lsum[hh] = 0.f;
    }
  };

  TileRegs tr;
#pragma unroll 1
  for (int hp = 0; hp < 2; ++hp) {
    load_q(hp);
    set_cut(slope[1]);
    float p3carry = 0.f;
    {
      const u16 *Kb, *Vb; size_t ldk, ldv;
      srcA(0, Kb, ldk, Vb, ldv);
      attn_prefetch(tr, Kb, ldk, Vb, ldv);
    }
#pragma unroll 1
    for (int e = 0; e < nA; ++e) {
      char* buf = smem + (e & 1) * 16384;
      attn_stage(tr, buf);
      __syncthreads();
      if (e + 1 < nA) {
        const u16 *Kb, *Vb; size_t ldk, ldv;
        srcA(e + 1, Kb, ldk, Vb, ldv);
        attn_prefetch(tr, Kb, ldk, Vb, ldv);
      }
      if (e < ncp) {
        attn_tile<0, true, false>(buf, qf, O, lsum, invl, slope, (float)((ct0 + e) * 1024 + 31 - tq), 16.f, 1e9f, true, imp, false, p3carry);
      } else if (e < 2 * ncp) {
        const int ct = ct0 + e - ncp;
        if (e == ncp) {
#pragma unroll
          for (int hh = 0; hh < 2; ++hh) { const float l = red4(lsum[hh]); invl[hh] = (l > 0.f) ? 1.f / l : 0.f; lsum[hh] = 0.f; }
          p3carry = 0.f;
        }
        attn_tile<1, true, false>(buf, qf, O, lsum, invl, slope, (float)(ct * 1024 + 31 - tq), 16.f, 1e9f, true,
                     imp + ql * 129 + ct * 16, true, p3carry);
      } else {
        if (e == 2 * ncp) fold(hp, 0);
        const int kb = kbs + e - 2 * ncp;
        const bool mk = (kb == qt) || (kb == qt - 8);
        if (mk) attn_tile<2, true, false>(buf, qf, O, lsum, invl, slope, (float)(kb * 64 - tq), 1.f, 512.f, true, imp, false, p3carry);
        else attn_tile<2, false, false>(buf, qf, O, lsum, invl, slope, (float)(kb * 64 - tq), 1.f, 512.f, true, imp, false, p3carry);
      }
    }
    fold(hp, 2);
    __syncthreads();
  }

  unsigned sel[4] = {0u, 0u, 0u, 0u};
  {
    unsigned key[32];
#pragma unroll
    for (int i = 0; i < 32; ++i) {
      const int j = g4 * 32 + i;
      const unsigned bits = __float_as_uint(imp[ql * 129 + j]);
      unsigned k = ((((bits >> 7) + 1u) << 7) & 0x7FFFFF80u) | (unsigned)(127 - j);
      if (j == 0 || j == qt || j == qt - 1) k = 0x80000000u | (unsigned)(127 - j);
      if (j > qt) k = 0u;
      key[i] = k;
    }
#pragma unroll 1
    for (int r = 0; r < 16; ++r) {
      unsigned m = 0u;
#pragma unroll
      for (int i = 0; i < 32; ++i) m = key[i] > m ? key[i] : m;
      unsigned o = __shfl_xor(m, 16); m = o > m ? o : m;
      o = __shfl_xor(m, 32); m = o > m ? o : m;
      if (m != 0u) {
        const int jw = 127 - (int)(m & 127u);
#pragma unroll
        for (int wi = 0; wi < 4; ++wi) sel[wi] |= ((jw >> 5) == wi) ? (1u << (jw & 31)) : 0u;
#pragma unroll
        for (int i = 0; i < 32; ++i) key[i] = (key[i] == m) ? 0u : key[i];
      }
    }
  }
  if (g4 == 0) {
#pragma unroll
    for (int wi = 0; wi < 4; ++wi) atomicOr(&uni[wi], sel[wi]);
  }
  __syncthreads();
  {
    const unsigned u0 = uni[0], u1 = uni[1], u2 = uni[2], u3 = uni[3];
    if (tid < 128) {
      const int j = tid, wi = j >> 5;
      const unsigned wv = wi == 0 ? u0 : wi == 1 ? u1 : wi == 2 ? u2 : u3;
      if ((wv >> (j & 31)) & 1u) {
        int pos = __popc(wv & ((1u << (j & 31)) - 1u));
        pos += (wi > 0 ? __popc(u0) : 0) + (wi > 1 ? __popc(u1) : 0) + (wi > 2 ? __popc(u2) : 0);
        list[pos] = j;
      }
    }
    if (tid == 0) *cntp = __popc(u0) + __popc(u1) + __popc(u2) + __popc(u3);
  }
  __syncthreads();
  const int nB = *cntp;

  float p3c2 = 0.f;
#pragma unroll 1
  for (int hp = 0; hp < 2; ++hp) {
    load_q(hp);
    int e0 = 0;
    {
      const float xs = ((float)q0 - 63.f - sm_s / slope[1]) * (1.f / 64.f);
      const int jmin = xs > 0.f ? (int)ceilf(xs) : 0;
      while (e0 < nB - 1 && list[e0] < jmin) ++e0;
    }
    {
      const int j0 = list[e0];
      attn_prefetch(tr, ksw + (size_t)(b * S_ + j0 * 64) * 512 + g * 64, 512, vst + j0 * 64, S_);
    }
#pragma unroll 1
    for (int e = e0; e < nB; ++e) {
      char* buf = smem + (e & 1) * 16384;
      const int j = list[e];
      attn_stage(tr, buf);
      __syncthreads();
      if (e + 1 < nB) {
        const int jn = list[e + 1];
        attn_prefetch(tr, ksw + (size_t)(b * S_ + jn * 64) * 512 + g * 64, 512, vst + jn * 64, S_);
      }
      const unsigned wsel = (j < 32) ? sel[0] : (j < 64) ? sel[1] : (j < 96) ? sel[2] : sel[3];
      const bool sl = (wsel >> (j & 31)) & 1u;
      if (j == qt) attn_tile<2, true, true>(buf, qf, O, lsum, invl, slope, (float)(j * 64 - tq), 1.f, 1e9f, sl, imp, false, p3c2);
      else attn_tile<2, false, true>(buf, qf, O, lsum, invl, slope, (float)(j * 64 - tq), 1.f, 1e9f, sl, imp, false, p3c2);
    }
    fold(hp, 1);
    __syncthreads();
  }
}

__device__ __forceinline__ void phase_attention(const Params& p, int l, char* smem) {
  unsigned* ctr = (unsigned*)(p.ws + OFF_BAR) + 3600 + 64 * l;
  int* slot = reinterpret_cast<int*>(smem + LDS_CNT + 8);
  const int tid = otid();
#pragma unroll 1
  for (;;) {
    if (tid == 0) *slot = (int)atomicAdd(ctr, 1u);
    __syncthreads();
    const int idx = *slot;
    __syncthreads();
    if (idx >= 2048) break;
    const int qt = 127 - (idx >> 4), g = 3 - ((idx >> 2) & 3), b = idx & 3;
    attn_item(p, l, b, g, qt, smem);
  }
}

__device__ __forceinline__ void phase_merge(const Params& p, int l, char* smem) {
  char* ws = optr(p.ws);
  const u16* xb = (const u16*)(ws + OFF_XB);
  const u16* bv = (const u16*)(ws + OFF_BV);
  const u16* att = (const u16*)(ws + OFF_ATT);
  const u16* wco = (const u16*)(ws + OFF_WCO) + (size_t)l * 1024 * 512;
  const u16* wmg = (const u16*)(ws + OFF_WMG) + (size_t)l * 2048 * 1024;
  u16* mrg = (u16*)(ws + OFF_MRG);
  const int tid = otid(), lane = tid & 63, w = tid >> 6, l15 = lane & 15, g4 = lane >> 4, wr = w >> 1, wc = w & 1;
  auto setup = [&](GUnit& u) {
    if (u.step == 0) {
      u.A = bv; u.B = wco; u.akstep = 64; u.nkt = 8;
      std_offsets(u.aoff, u.m0, 512); std_offsets(u.boff, u.n0, 512);
    } else {
      u.A = xb; u.B = wmg; u.akstep = 64; u.nkt = 16;
      std_offsets(u.aoff, u.m0, 1024); std_offsets(u.boff, (u.step - 1) * 1024 + u.n0, 1024);
    }
  };
  auto epi = [&](const GUnit& u, f32x4 (&acc)[4][4]) {
    const int m0 = u.m0, n0 = u.n0, step = u.step;
#pragma unroll
    for (int mt = 0; mt < 4; ++mt) {
      const int m = m0 + wr * 64 + mt * 16 + l15;
#pragma unroll
      for (int np = 0; np < 2; ++np) {
        const int n = n0 + wc * 64 + np * 32 + g4 * 8;
        u32x4* dst = reinterpret_cast<u32x4*>(mrg + (size_t)m * 1024 + n);
        float r[8];
#pragma unroll
        for (int j = 0; j < 4; ++j) { r[j] = acc[mt][2 * np][j]; r[4 + j] = acc[mt][2 * np + 1][j]; }
        if (step == 1) {
          const u32x4 o = *dst;
#pragma unroll
          for (int q = 0; q < 4; ++q) { r[2 * q] = sigmoidf_(r[2 * q]) * bflo(o[q]); r[2 * q + 1] = sigmoidf_(r[2 * q + 1]) * bfhi(o[q]); }
        } else if (step == 2) {
          const u32x4 o = *dst;
          const u32x4 a = *reinterpret_cast<const u32x4*>(att + (size_t)m * 1024 + n);
#pragma unroll
          for (int q = 0; q < 4; ++q) {
            r[2 * q] = bflo(o[q]) + sigmoidf_(r[2 * q]) * bflo(a[q]);
            r[2 * q + 1] = bfhi(o[q]) + sigmoidf_(r[2 * q + 1]) * bfhi(a[q]);
          }
        }
        u32x4 o2; o2[0] = pack2(r[0], r[1]); o2[1] = pack2(r[2], r[3]); o2[2] = pack2(r[4], r[5]); o2[3] = pack2(r[6], r[7]);
        *dst = o2;
      }
    }
  };
  gemm_stream<3>(8, setup, epi, smem);
}

__device__ __forceinline__ void phase_resgemm(const Params& p, const u16* A, int K, const u16* Bt, const float* resid,
                                              const float* pg, const float* pb, char* smem) {
  const float2* stat = (const float2*)(optr(p.ws) + OFF_STAT);
  float* out = p.out;
  const int tid = otid(), lane = tid & 63, w = tid >> 6, l15 = lane & 15, g4 = lane >> 4, wr = w >> 1, wc = w & 1;
  auto setup = [&](GUnit& u) {
    u.A = A; u.B = Bt; u.akstep = 64; u.nkt = K / 64;
    std_offsets(u.aoff, u.m0, K); std_offsets(u.boff, u.n0, K);
  };
  auto epi = [&](const GUnit& u, f32x4 (&acc)[4][4]) {
    const int m0 = u.m0, n0 = u.n0;
#pragma unroll
    for (int mt = 0; mt < 4; ++mt) {
      const int m = m0 + wr * 64 + mt * 16 + l15;
#pragma unroll
      for (int nt = 0; nt < 4; ++nt) {
        const int n = n0 + wc * 64 + (nt >> 1) * 32 + g4 * 8 + (nt & 1) * 4;
        float4 r;
        if (resid) {
          r = *reinterpret_cast<const float4*>(resid + (size_t)m * 1024 + n);
        } else {
          const float4 y = *reinterpret_cast<const float4*>(out + (size_t)m * 1024 + n);
          const float2 st = stat[m];
          const float4 gg = *reinterpret_cast<const float4*>(pg + n);
          const float4 bb = *reinterpret_cast<const float4*>(pb + n);
          r.x = (y.x - st.x) * st.y * gg.x + bb.x; r.y = (y.y - st.x) * st.y * gg.y + bb.y;
          r.z = (y.z - st.x) * st.y * gg.z + bb.z; r.w = (y.w - st.x) * st.y * gg.w + bb.w;
        }
        float4 o;
        o.x = ALPHA * r.x + acc[mt][nt][0]; o.y = ALPHA * r.y + acc[mt][nt][1];
        o.z = ALPHA * r.z + acc[mt][nt][2]; o.w = ALPHA * r.w + acc[mt][nt][3];
        *reinterpret_cast<float4*>(out + (size_t)m * 1024 + n) = o;
      }
    }
  };
  gemm_stream<1>(8, setup, epi, smem);
}

__device__ __forceinline__ void phase_ln(const Params& p, const float* gam, const float* bet, bool write_f32) {
  float* out = p.out;
  u16* xb = (u16*)(p.ws + OFF_XB);
  float2* stat = (float2*)(p.ws + OFF_STAT);
  const int lane = otid() & 63;
  const int gw = (blockIdx.x * 256 + otid()) >> 6, nw = gridDim.x * 4;
#pragma unroll 1
  for (int row0 = gw; row0 < T_; row0 += 2 * nw) {
    const int row1 = row0 + nw;
    const bool has1 = row1 < T_;
    const float* r0p = out + (size_t)row0 * 1024 + lane * 4;
    const float* r1p = out + (size_t)(has1 ? row1 : row0) * 1024 + lane * 4;
    f32x4 a0 = *reinterpret_cast<const f32x4*>(r0p), a1 = *reinterpret_cast<const f32x4*>(r0p + 256);
    f32x4 a2 = *reinterpret_cast<const f32x4*>(r0p + 512), a3 = *reinterpret_cast<const f32x4*>(r0p + 768);
    f32x4 b0 = *reinterpret_cast<const f32x4*>(r1p), b1 = *reinterpret_cast<const f32x4*>(r1p + 256);
    f32x4 b2 = *reinterpret_cast<const f32x4*>(r1p + 512), b3 = *reinterpret_cast<const f32x4*>(r1p + 768);
    f32x4 ta = a0 + a1 + a2 + a3, tb = b0 + b1 + b2 + b3;
    float sa = ta[0] + ta[1] + ta[2] + ta[3], sb = tb[0] + tb[1] + tb[2] + tb[3];
    for (int o = 32; o > 0; o >>= 1) { sa += __shfl_xor(sa, o); sb += __shfl_xor(sb, o); }
    const float mua = sa * (1.f / 1024.f), mub = sb * (1.f / 1024.f);
    a0 -= mua; a1 -= mua; a2 -= mua; a3 -= mua;
    b0 -= mub; b1 -= mub; b2 -= mub; b3 -= mub;
    ta = a0 * a0 + a1 * a1 + a2 * a2 + a3 * a3; tb = b0 * b0 + b1 * b1 + b2 * b2 + b3 * b3;
    float qa = ta[0] + ta[1] + ta[2] + ta[3], qb = tb[0] + tb[1] + tb[2] + tb[3];
    for (int o = 32; o > 0; o >>= 1) { qa += __shfl_xor(qa, o); qb += __shfl_xor(qb, o); }
    const float rsa = rsqrtf(qa * (1.f / 1024.f) + 1e-5f), rsb = rsqrtf(qb * (1.f / 1024.f) + 1e-5f);
    if (!write_f32 && lane == 0) {
      stat[row0] = make_float2(mua, rsa);
      if (has1) stat[row1] = make_float2(mub, rsb);
    }
#define LN_OUT(V, RS, ROW, C)                                                                       \
    {                                                                                               \
      const f32x4 gg = *reinterpret_cast<const f32x4*>(gam + (C) + lane * 4);                       \
      const f32x4 bb = *reinterpret_cast<const f32x4*>(bet + (C) + lane * 4);                       \
      const f32x4 o = V * RS * gg + bb;                                                             \
      if (write_f32) {     \
        *reinterpret_cast<f32x4*>(out + (size_t)(ROW) * 1024 + (C) + lane * 4) = o;                 \
      } else {                                                                                      \
        u32x2 ob; ob[0] = pack2(o[0], o[1]); ob[1] = pack2(o[2], o[3]);                             \
        *reinterpret_cast<u32x2*>(xb + (size_t)(ROW) * 1024 + (C) + lane * 4) = ob;                 \
      }                                                                                             \
    }
    LN_OUT(a0, rsa, row0, 0) LN_OUT(a1, rsa, row0, 256) LN_OUT(a2, rsa, row0, 512) LN_OUT(a3, rsa, row0, 768)
    if (has1) { LN_OUT(b0, rsb, row1, 0) LN_OUT(b1, rsb, row1, 256) LN_OUT(b2, rsb, row1, 512) LN_OUT(b3, rsb, row1, 768) }
#undef LN_OUT
  }
}

__device__ __forceinline__ void phase_ffn1(const Params& p, int l, char* smem) {
  char* ws = optr(p.ws);
  const u16* A = (const u16*)(ws + OFF_XB);
  const u16* B = (const u16*)(ws + OFF_WF1) + (size_t)l * 5632 * 1024;
  u16* hb = (u16*)(ws + OFF_H);
  const int tid = otid(), lane = tid & 63, w = tid >> 6, l15 = lane & 15, g4 = lane >> 4, wr = w >> 1, wc = w & 1;
  auto setup = [&](GUnit& u) {
    u.A = A; u.B = B; u.akstep = 64; u.nkt = 16;
    std_offsets(u.aoff, u.m0, 1024); std_offsets(u.boff, u.n0, 1024);
  };
  auto epi = [&](const GUnit& u, f32x4 (&acc)[4][4]) {
    const int m0 = u.m0, nt_ = u.n0 >> 7;
#pragma unroll
    for (int mt = 0; mt < 4; ++mt) {
      const int m = m0 + wr * 64 + mt * 16 + l15;
      float hv[8];
#pragma unroll
      for (int q = 0; q < 2; ++q)
#pragma unroll
        for (int j = 0; j < 4; ++j) {
          const float a = acc[mt][q][j], uu = acc[mt][q + 2][j];
          hv[q * 4 + j] = a * sigmoidf_(a) * uu;
        }
      u32x4 o; o[0] = pack2(hv[0], hv[1]); o[1] = pack2(hv[2], hv[3]); o[2] = pack2(hv[4], hv[5]); o[3] = pack2(hv[6], hv[7]);
      *reinterpret_cast<u32x4*>(hb + (size_t)m * DFF + (nt_ * 2 + wc) * 32 + g4 * 8) = o;
    }
  };
  gemm_stream<1>(44, setup, epi, smem);
}

#define XB_TMO      128
#define XB_XCNT(j)  (256  + 64 * (j))
#define XB_XSUB(j)  (1280 + 64 * (j))
#define XB_XGEN(j)  (2304 + 64 * (j))
#define XB_TOP      3328
#define XB_TOPGEN   3392
#define XCD_BAR_WORDS 3456
#define XB_SPIN_CAP (1u << 18)
#define LAS __attribute__((address_space(3)))

__device__ __forceinline__ unsigned xb_ld(unsigned* p)              { return __hip_atomic_load(p, __ATOMIC_RELAXED, __HIP_MEMORY_SCOPE_AGENT); }
__device__ __forceinline__ unsigned xb_add(unsigned* p, unsigned v) { return __hip_atomic_fetch_add(p, v, __ATOMIC_RELAXED, __HIP_MEMORY_SCOPE_AGENT); }
__device__ __forceinline__ unsigned xb_xcc_id() { return (unsigned)__builtin_amdgcn_s_getreg((3 << 11) | 20) & 0xFu; }
#define XB_SPIN(cond, bar) do { unsigned _sp = 0; while (cond) { __builtin_amdgcn_s_sleep(1); \
    if ((++_sp & 255u) == 0u) { if (xb_ld(&(bar)[XB_TMO])) break; if (_sp > XB_SPIN_CAP) { atomicAdd(&(bar)[XB_TMO], 1u); break; } } } } while (0)

struct XcdBarrier {
    unsigned* bar; unsigned x;
    volatile LAS unsigned* st;
};

__device__ __forceinline__ XcdBarrier xcd_barrier_post(unsigned* bar, volatile LAS unsigned* st) {
    XcdBarrier b; b.bar = bar; b.x = xb_xcc_id(); b.st = st;
    if (threadIdx.x == 0) (void)xb_add(&bar[XB_XCNT(b.x)], 1u);
    return b;
}
__device__ __forceinline__ void xcd_barrier_complete(unsigned* bar, unsigned x, unsigned& nloc, unsigned& nx) {
    const unsigned G = gridDim.x * gridDim.y * gridDim.z;
    unsigned sum, cnt, mine, sp = 0u;
    for (;;) {
        sum = 0u; cnt = 0u; mine = 0u;
#pragma unroll
        for (unsigned j = 0; j < 16; ++j) { const unsigned c = xb_ld(&bar[XB_XCNT(j)]); sum += c; cnt += (c > 0u) ? 1u : 0u; mine = (j == x) ? c : mine; }
        if (sum == G) break;
        __builtin_amdgcn_s_sleep(1);
        if ((++sp & 255u) == 0u) { if (xb_ld(&bar[XB_TMO])) break; if (sp > XB_SPIN_CAP) { atomicAdd(&bar[XB_TMO], 1u); break; } }
    }
    nloc = mine > 0u ? mine : 1u; nx = cnt > 0u ? cnt : 1u;
}

__device__ __forceinline__ void xcd_barrier(const XcdBarrier& b) {
    asm volatile("s_waitcnt vmcnt(0)" ::: "memory");
    __syncthreads();
    if (threadIdx.x == 0) {
        unsigned* bar = b.bar;
        __builtin_amdgcn_s_waitcnt(0);
        unsigned nloc = b.st[0], nx = b.st[1];
        if (nloc == 0u) { xcd_barrier_complete(bar, b.x, nloc, nx); b.st[0] = nloc; b.st[1] = nx; }
        const unsigned old = xb_add(&bar[XB_XSUB(b.x)], 1u);
        const unsigned gen = old / nloc;
        if (old + 1u == (gen + 1u) * nloc) {
            __builtin_amdgcn_fence(__ATOMIC_RELEASE, "agent");
            asm volatile("s_waitcnt vmcnt(0)" ::: "memory");
            const unsigned og = xb_add(&bar[XB_TOP], 1u);
            const unsigned tg = og / nx;
            if (og + 1u == (tg + 1u) * nx) xb_add(&bar[XB_TOPGEN], 1u);
            else XB_SPIN(xb_ld(&bar[XB_TOPGEN]) == tg, bar);
            __builtin_amdgcn_fence(__ATOMIC_ACQUIRE, "agent");
            xb_add(&bar[XB_XGEN(b.x)], 1u);
            asm volatile("s_waitcnt vmcnt(0)" ::: "memory");
        } else {
            XB_SPIN(xb_ld(&bar[XB_XGEN(b.x)]) == gen, bar);
            __builtin_amdgcn_fence(__ATOMIC_ACQUIRE, "agent");
            asm volatile("s_waitcnt vmcnt(0)" ::: "memory");
        }
    }
    __syncthreads();
}


__global__ void __launch_bounds__(256, 2) mega(Params p) {
  __shared__ __attribute__((aligned(16))) char smem[SMEM_BYTES];
  __shared__ uint4 xb_words;
  if (threadIdx.x == 0) xb_words = make_uint4(0u, 0u, 0u, 0u);
  __syncthreads();
  XcdBarrier xb = xcd_barrier_post((unsigned*)(p.ws + OFF_BAR), (volatile LAS unsigned*)&xb_words);
  for (int ph = p.phase_begin; ph < p.phase_end; ++ph) {
    if (ph > p.phase_begin) {
      if (p.phase_end < 0) cg::this_grid().sync();
      xcd_barrier(xb);
    }
    if (ph == 0) { if (PH_MASK & 1) phase_prologue(p, smem); continue; }
    const int l = (ph - 1) / 9, k = (ph - 1) % 9;
    for (int rep = 0; rep <= ((REP_MASK >> k) & 1); ++rep)
    switch (k) {
      case 0: if (PH_MASK & (2<<0)) phase_gemm1(p, l, smem); break;
      case 1: if (PH_MASK & (2<<1)) phase_conv_compress(p, l, smem); break;
      case 2: if (PH_MASK & (2<<2)) phase_attention(p, l, smem); break;
      case 3: if (PH_MASK & (2<<3)) phase_merge(p, l, smem); break;
      case 4: if (PH_MASK & (2<<4)) phase_resgemm(p, (const u16*)(p.ws + OFF_MRG), 1024, (const u16*)(p.ws + OFF_WO) + (size_t)l * 1024 * 1024,
                            l == 0 ? p.x : nullptr, p.ln2_g, p.ln2_b, smem); break;
      case 5: if (PH_MASK & (2<<5)) phase_ln(p, p.ln1_g + l * 1024, p.ln1_b + l * 1024, false); break;
      case 6: if (PH_MASK & (2<<6)) phase_ffn1(p, l, smem); break;
      case 7: if (PH_MASK & (2<<7)) phase_resgemm(p, (const u16*)(p.ws + OFF_H), DFF, (const u16*)(p.ws + OFF_WF2) + (size_t)l * 1024 * DFF,
                            nullptr, p.ln1_g + l * 1024, p.ln1_b + l * 1024, smem); break;
      case 8: if (PH_MASK & (2<<8)) phase_ln(p, p.ln2_g + l * 1024, p.ln2_b + l * 1024, l == 1); break;
    }
  }
}

extern "C" void kernel_launch(void* const* d_in, const int* in_sizes, int n_in, void* d_out, int out_size, void* d_ws,
                              size_t ws_size, hipStream_t stream) {
  static int grid_blocks = 0;
  if (!grid_blocks) {
    int dev = 0, cus = 0, per_cu = 0;
    hipGetDevice(&dev);
    hipDeviceGetAttribute(&cus, hipDeviceAttributeMultiprocessorCount, dev);
    hipOccupancyMaxActiveBlocksPerMultiprocessor(&per_cu, mega, 256, 0);
    if (per_cu < 1) per_cu = 1;
    if (per_cu > 2) per_cu = 2;
    grid_blocks = (cus * per_cu) & ~7;
    if (grid_blocks < 8) grid_blocks = 8;
  }
  if (ws_size < OFF_END) fprintf(stderr, "workspace too small: %zu < %zu\n", ws_size, (size_t)OFF_END);
  Params p{};
  p.x = (const float*)d_in[0]; p.w_in = (const float*)d_in[1]; p.conv_w = (const float*)d_in[2];
  p.w_conv_out = (const float*)d_in[3]; p.cmp_pos = (const float*)d_in[4]; p.cmp_w1 = (const float*)d_in[5];
  p.cmp_b1 = (const float*)d_in[6]; p.cmp_w2 = (const float*)d_in[7]; p.w_o = (const float*)d_in[8];
  p.ln1_g = (const float*)d_in[9]; p.ln1_b = (const float*)d_in[10]; p.w_ffn_in = (const float*)d_in[11];
  p.w_ffn_out = (const float*)d_in[12]; p.ln2_g = (const float*)d_in[13]; p.ln2_b = (const float*)d_in[14];
  p.out = (float*)d_out; p.ws = (char*)d_ws;
  hipMemsetAsync((char*)d_ws + OFF_BAR, 0, 16384, stream);
#if ONE_LAUNCH
  p.phase_begin = 0; p.phase_end = 19;
  void* args[] = {&p};
  hipError_t e = hipLaunchCooperativeKernel((void*)mega, dim3(grid_blocks), dim3(256), args, 0, stream);
  if (e != hipSuccess) fprintf(stderr, "cooperative launch failed: %s (grid %d)\n", hipGetErrorString(e), grid_blocks);
#else
  for (int ph = 0; ph < 19; ++ph) {
    p.phase_begin = ph; p.phase_end = ph + 1;
    mega<<<grid_blocks, 256, 0, stream>>>(p);
  }
#endif
}
```
